# Optimizing an MI355X kernel written in HIP

```python
import jax
import jax.numpy as jnp
from jax import lax
import numpy as np

D_MODEL = 1024
BATCH = 8
SEQ = 4096
DEPTH = 2

GRID_W = 64
CTX_LEN = 256
HEAD_DIM = 64
NA_HEADS = 8
NA_WIDTH = NA_HEADS * HEAD_DIM
NA_WIN_ROWS = 8
NA_WIN_COLS = 16
NA_QBLOCK_COLS = 16
NA_KBLOCK_COLS = 2 * NA_WIN_COLS
LRU_WIDTH = D_MODEL // 2
LRU_BLOCKS = 8
LRU_BLOCK = LRU_WIDTH // LRU_BLOCKS
LRU_CONV_W = 4
LRU_C = 8.0
MIX_WIDTH = NA_WIDTH + LRU_WIDTH
MIX_IN_WIDTH = 3 * NA_WIDTH + 2 * LRU_WIDTH
FNET_GROUPS = 4
N_EXPERTS = 16
N_EXPERT_GROUPS = 4
EXPERTS_PER_GROUP = N_EXPERTS // N_EXPERT_GROUPS
TOP_K = 2
D_FF_EXPERT = 512
N_EVEN_LAYERS = (DEPTH + 1) // 2
N_ODD_LAYERS = DEPTH // 2
RMS_EPS = 1e-6
MASK_VALUE = -1e30

kernel_name = "hybrid_na_rglru_fnet_grouped_moe"


def rmsnorm(x, gain):
    xf = x.astype(jnp.float32)
    y = xf * lax.rsqrt(jnp.mean(xf * xf, axis=-1, keepdims=True) + RMS_EPS)
    return (y * gain.astype(jnp.float32)).astype(x.dtype)


def modulate(h, shift, scale):
    return h * (1 + scale) + shift


def na_tables(rows):
    kr = min(NA_WIN_ROWS, rows)
    r = np.arange(rows)
    row_start = np.clip(r - kr // 2, 0, rows - kr)
    key_rows = row_start[:, None] + np.arange(kr)
    ncb = GRID_W // NA_QBLOCK_COLS
    c0 = np.arange(ncb) * NA_QBLOCK_COLS
    kb = np.clip(c0 - NA_WIN_COLS // 2, 0, GRID_W - NA_KBLOCK_COLS)
    key_cols = kb[:, None] + np.arange(NA_KBLOCK_COLS)
    q_cols = c0[:, None] + np.arange(NA_QBLOCK_COLS)
    col_start = np.clip(q_cols - NA_WIN_COLS // 2, 0, GRID_W - NA_WIN_COLS)
    idx = (key_rows[:, None, :, None] * GRID_W + key_cols[None, :, None, :]).reshape(rows, ncb, kr * NA_KBLOCK_COLS)
    kc = key_cols[:, None, :]
    valid = (kc >= col_start[..., None]) & (kc < col_start[..., None] + NA_WIN_COLS)
    dr = key_rows - r[:, None] + (NA_WIN_ROWS - 1)
    dc = np.clip(kc - q_cols[..., None], 1 - NA_WIN_COLS, NA_WIN_COLS - 1) + (NA_WIN_COLS - 1)
    return idx.astype(np.int32), valid, dr, dc, kr


def neighbourhood_attention(q, k, v, k_ctx, v_ctx, rpb):
    B, N, H, dh = q.shape
    rows = N // GRID_W
    ncb = GRID_W // NA_QBLOCK_COLS
    idx, valid, dr, dc, kr = na_tables(rows)
    n_keys = kr * NA_KBLOCK_COLS
    bias = rpb.astype(jnp.float32)[:, dr[:, None, None, :, None], dc[None, :, :, None, :]]
    bias = jnp.where(valid[None, None, :, :, None, :], bias, MASK_VALUE)
    bias = bias.transpose(1, 0, 2, 3, 4, 5).reshape(rows, H, ncb, NA_QBLOCK_COLS, n_keys)
    q_rows = q.reshape(B, rows, ncb, NA_QBLOCK_COLS, H, dh).transpose(1, 0, 2, 3, 4, 5)

    def row_block(args):
        q_r, idx_r, bias_r = args
        k_g = jnp.take(k, idx_r, axis=1)
        v_g = jnp.take(v, idx_r, axis=1)
        s_win = jnp.einsum("bcqhd,bckhd->bhcqk", q_r, k_g, preferred_element_type=jnp.float32) + bias_r[None]
        s_ctx = jnp.einsum("bcqhd,bjhd->bhcqj", q_r, k_ctx, preferred_element_type=jnp.float32)
        p = jax.nn.softmax(jnp.concatenate([s_win, s_ctx], axis=-1), axis=-1).astype(v.dtype)
        return (jnp.einsum("bhcqk,bckhd->bcqhd", p[..., :n_keys], v_g)
                + jnp.einsum("bhcqj,bjhd->bcqhd", p[..., n_keys:], v_ctx))

    o = lax.map(row_block, (q_rows, jnp.asarray(idx), bias))
    return o.transpose(1, 0, 2, 3, 4, 5).reshape(B, N, H * dh)


def centred_depthwise_conv(x, w, b):
    T = x.shape[1]
    lo = LRU_CONV_W // 2
    xp = jnp.pad(x, ((0, 0), (lo, LRU_CONV_W - 1 - lo), (0, 0)))
    y = b
    for tap in range(LRU_CONV_W):
        y = y + w[tap] * xp[:, tap:tap + T]
    return y


def rglru_coeffs(xc, w_r, b_r, w_i, b_i, lam):
    B, T, W = xc.shape
    xb = xc.reshape(B, T, LRU_BLOCKS, LRU_BLOCK)
    r = jax.nn.sigmoid(jnp.einsum("bthi,hij->bthj", xb, w_r.astype(jnp.float32)).reshape(B, T, W) + b_r.astype(jnp.float32))
    i = jax.nn.sigmoid(jnp.einsum("bthi,hij->bthj", xb, w_i.astype(jnp.float32)).reshape(B, T, W) + b_i.astype(jnp.float32))
    log_a = -LRU_C * r * jax.nn.softplus(-lam.astype(jnp.float32))
    return jnp.exp(log_a), jnp.sqrt(-jnp.expm1(2.0 * log_a)) * (i * xc)


def linear_scan(a, b):
    def combine(left, right):
        return left[0] * right[0], right[0] * left[1] + right[1]
    return lax.associative_scan(combine, (a, b), axis=1)


def bidirectional_rglru(x_lat, x_ctx, w_r, b_r, w_i, b_i, lam):
    x_lat = x_lat.astype(jnp.float32)
    x_ctx = x_ctx.astype(jnp.float32)
    outs = []
    for d in range(2):
        a_c, b_c = rglru_coeffs(x_ctx, w_r[d], b_r[d], w_i[d], b_i[d], lam[d])
        a_l, b_l = rglru_coeffs(x_lat, w_r[d], b_r[d], w_i[d], b_i[d], lam[d])
        if d == 1:
            a_c, b_c, a_l, b_l = (jnp.flip(t, axis=1) for t in (a_c, b_c, a_l, b_l))
        h0 = linear_scan(a_c, b_c)[1][:, -1]
        a_prefix, h_l = linear_scan(a_l, b_l)
        h = h_l + a_prefix * h0[:, None, :]
        if d == 1:
            h = jnp.flip(h, axis=1)
        outs.append(h)
    return outs[0] + outs[1]


def grouped_moe(h, router_w, router_bias, w_gate, w_up, w_down):
    B, T, D = h.shape
    scores = jax.nn.sigmoid(jnp.einsum("btd,de->bte", h, router_w, preferred_element_type=jnp.float32))
    sel = scores + router_bias.astype(jnp.float32)
    grp = sel.reshape(B, T, N_EXPERT_GROUPS, EXPERTS_PER_GROUP)
    grp_score = lax.top_k(grp, TOP_K)[0].sum(-1)
    best = jnp.argmax(grp_score, axis=-1)
    in_group = (jnp.arange(N_EXPERTS) // EXPERTS_PER_GROUP)[None, None, :] == best[..., None]
    _, idx = lax.top_k(jnp.where(in_group, sel, -jnp.inf), TOP_K)
    w = jnp.take_along_axis(scores, idx, axis=-1)
    w = w / jnp.sum(w, axis=-1, keepdims=True)
    gates = jnp.sum(jax.nn.one_hot(idx, N_EXPERTS, dtype=jnp.float32) * w[..., None], axis=-2).astype(h.dtype)
    out = jnp.zeros_like(h)
    for e in range(N_EXPERTS):
        y = (jax.nn.silu(h @ w_gate[e]) * (h @ w_up[e])) @ w_down[e]
        out = out + gates[..., e:e + 1] * y
    return out


def setup_inputs(seed: int = 0) -> dict:
    key = jax.random.key(seed)
    keys = iter(jax.random.split(key, 32))
    D = D_MODEL

    def nrm(shape, scale):
        return jax.random.normal(next(keys), shape, jnp.float32) * scale

    x = nrm((BATCH, SEQ, D), 1.0)
    c = nrm((BATCH, D), 1.0)
    ctx = nrm((BATCH, CTX_LEN, D), 1.0)
    c_ctx = nrm((D,), 1.0)
    ada_w = nrm((DEPTH, D, 6 * D), 0.5 * D ** -0.5)
    ada_b = nrm((DEPTH, 6 * D), 0.02)
    norm_mix = 1.0 + nrm((DEPTH, D), 0.02)
    norm_ffn = 1.0 + nrm((DEPTH, D), 0.02)
    mix_w_in = nrm((N_EVEN_LAYERS, D, MIX_IN_WIDTH), D ** -0.5)
    mix_w_out = nrm((N_EVEN_LAYERS, MIX_WIDTH, D), MIX_WIDTH ** -0.5)
    na_q_norm = 1.0 + nrm((N_EVEN_LAYERS, HEAD_DIM), 0.02)
    na_k_norm = 1.0 + nrm((N_EVEN_LAYERS, HEAD_DIM), 0.02)
    na_rpb = nrm((N_EVEN_LAYERS, NA_HEADS, 2 * NA_WIN_ROWS - 1, 2 * NA_WIN_COLS - 1), 0.5)
    lru_conv_w = nrm((N_EVEN_LAYERS, LRU_CONV_W, LRU_WIDTH), LRU_CONV_W ** -0.5)
    lru_conv_b = nrm((N_EVEN_LAYERS, LRU_WIDTH), 0.02)
    lru_gate_r_w = nrm((N_EVEN_LAYERS, 2, LRU_BLOCKS, LRU_BLOCK, LRU_BLOCK), LRU_BLOCK ** -0.5)
    lru_gate_r_b = nrm((N_EVEN_LAYERS, 2, LRU_WIDTH), 0.02)
    lru_gate_i_w = nrm((N_EVEN_LAYERS, 2, LRU_BLOCKS, LRU_BLOCK, LRU_BLOCK), LRU_BLOCK ** -0.5)
    lru_gate_i_b = nrm((N_EVEN_LAYERS, 2, LRU_WIDTH), 0.02)
    a_pow_c = jax.random.uniform(next(keys), (N_EVEN_LAYERS, 2, LRU_WIDTH), jnp.float32, 0.9, 0.999)
    a0 = a_pow_c ** (1.0 / LRU_C)
    lru_lambda = jnp.log(a0) - jnp.log1p(-a0)
    fnet_w_out = nrm((N_ODD_LAYERS, D, D), D ** -0.5)
    router_w = nrm((D, N_EXPERTS), D ** -0.5)
    router_bias = nrm((N_EXPERTS,), 0.01)
    moe_w_gate = nrm((DEPTH, N_EXPERTS, D, D_FF_EXPERT), D ** -0.5)
    moe_w_up = nrm((DEPTH, N_EXPERTS, D, D_FF_EXPERT), D ** -0.5)
    moe_w_down = nrm((DEPTH, N_EXPERTS, D_FF_EXPERT, D), D_FF_EXPERT ** -0.5)
    return {"x": x, "c": c, "ctx": ctx, "c_ctx": c_ctx, "ada_w": ada_w, "ada_b": ada_b,
            "norm_mix": norm_mix, "norm_ffn": norm_ffn, "mix_w_in": mix_w_in, "mix_w_out": mix_w_out,
            "na_q_norm": na_q_norm, "na_k_norm": na_k_norm, "na_rpb": na_rpb,
            "lru_conv_w": lru_conv_w, "lru_conv_b": lru_conv_b,
            "lru_gate_r_w": lru_gate_r_w, "lru_gate_r_b": lru_gate_r_b,
            "lru_gate_i_w": lru_gate_i_w, "lru_gate_i_b": lru_gate_i_b, "lru_lambda": lru_lambda,
            "fnet_w_out": fnet_w_out, "router_w": router_w, "router_bias": router_bias,
            "moe_w_gate": moe_w_gate, "moe_w_up": moe_w_up, "moe_w_down": moe_w_down}


def reference(x, c, ctx, c_ctx, ada_w, ada_b, norm_mix, norm_ffn, mix_w_in, mix_w_out,
              na_q_norm, na_k_norm, na_rpb, lru_conv_w, lru_conv_b,
              lru_gate_r_w, lru_gate_r_b, lru_gate_i_w, lru_gate_i_b, lru_lambda,
              fnet_w_out, router_w, router_bias, moe_w_gate, moe_w_up, moe_w_down):
    B, N, D = x.shape
    silu_c = jax.nn.silu(c)
    silu_c_ctx = jax.nn.silu(c_ctx)

    def heads(t):
        return t.reshape(t.shape[0], t.shape[1], NA_HEADS, HEAD_DIM)

    for layer in range(DEPTH):
        li = layer // 2
        mod = silu_c @ ada_w[layer] + ada_b[layer]
        shift1, scale1, gate1, shift2, scale2, gate2 = jnp.split(mod[:, None, :], 6, axis=-1)
        h = modulate(rmsnorm(x, norm_mix[layer]), shift1, scale1)
        if layer % 2 == 0:
            mod_ctx = silu_c_ctx @ ada_w[layer, :, :2 * D] + ada_b[layer, :2 * D]
            h_ctx = modulate(rmsnorm(ctx, norm_mix[layer]), mod_ctx[:D], mod_ctx[D:])
            w_in = mix_w_in[li]
            q, k, v, xb, gb = jnp.split(h @ w_in, [NA_WIDTH, 2 * NA_WIDTH, 3 * NA_WIDTH, 3 * NA_WIDTH + LRU_WIDTH], axis=-1)
            k_c, v_c, xb_c = jnp.split(h_ctx @ w_in[:, NA_WIDTH:3 * NA_WIDTH + LRU_WIDTH], [NA_WIDTH, 2 * NA_WIDTH], axis=-1)
            q = rmsnorm(heads(q), na_q_norm[li]) * HEAD_DIM ** -0.5
            k = rmsnorm(heads(k), na_k_norm[li])
            k_c = rmsnorm(heads(k_c), na_k_norm[li])
            attn = neighbourhood_attention(q, k, heads(v), k_c, heads(v_c), na_rpb[li])
            xc_lat = centred_depthwise_conv(xb, lru_conv_w[li], lru_conv_b[li])
            xc_ctx = centred_depthwise_conv(xb_c, lru_conv_w[li], lru_conv_b[li])
            y = bidirectional_rglru(xc_lat, xc_ctx, lru_gate_r_w[li], lru_gate_r_b[li],
                                    lru_gate_i_w[li], lru_gate_i_b[li], lru_lambda[li])
            lru = jax.nn.gelu(gb) * y.astype(gb.dtype)
            mix = jnp.concatenate([attn, lru], axis=-1) @ mix_w_out[li]
        else:
            hg = h.astype(jnp.float32).reshape(B, N, FNET_GROUPS, D // FNET_GROUPS)
            f = jnp.fft.fft2(hg, axes=(1, 3), norm="ortho").real.reshape(B, N, D).astype(x.dtype)
            mix = f @ fnet_w_out[li]
        x = x + gate1 * mix
        h2 = modulate(rmsnorm(x, norm_ffn[layer]), shift2, scale2)
        x = x + gate2 * grouped_moe(h2, router_w, router_bias, moe_w_gate[layer], moe_w_up[layer], moe_w_down[layer])
    return x
```

```cpp
#include <hip/hip_runtime.h>
#include <stdint.h>
#include <stdio.h>

#ifndef MK_MULTI
#define MK_MULTI 0
#endif

#ifndef MK_LAST_PHASE
#define MK_LAST_PHASE 17
#endif
#define DEV __device__ __forceinline__
#define LAS __attribute__((address_space(3)))
typedef unsigned short bf16_t;
typedef short bf16x8 __attribute__((ext_vector_type(8)));
typedef float f32x2 __attribute__((ext_vector_type(2)));
typedef float f32x4 __attribute__((ext_vector_type(4)));
typedef float f32x16 __attribute__((ext_vector_type(16)));
typedef unsigned u32x4 __attribute__((ext_vector_type(4)));
typedef unsigned u32x2 __attribute__((ext_vector_type(2)));
typedef int i32x8 __attribute__((ext_vector_type(8)));
typedef int i32x4 __attribute__((ext_vector_type(4)));

constexpr int DM = 1024, NB = 8, SEQ = 4096, MTOK = NB * SEQ, CTXL = 256, MCTX = NB * CTXL, MALL = MTOK + MCTX;
constexpr int NPAIR = 24, LISTCAP = 32768, HIDROWS = 38912;
constexpr float LOG2E = 1.4426950408889634f;
constexpr int NTHREADS = 512;

constexpr size_t KB_ = 1024, MB_ = 1024 * 1024;
constexpr size_t WS_BAR   = 0;
constexpr size_t WS_CNT   = 16 * KB_;
constexpr size_t WS_MOD   = 64 * KB_;
constexpr size_t WS_ZERO_BYTES = 512 * KB_;
constexpr size_t WS_RPB2  = 512 * KB_;
constexpr size_t WS_LA8   = WS_RPB2 + 16 * KB_;
constexpr size_t WS_F1    = WS_LA8 + 4 * KB_;
constexpr size_t WS_F2    = WS_F1 + 16 * KB_;
constexpr size_t WS_TW    = WS_F2 + 32 * KB_;
constexpr size_t WS_CS    = WS_TW + 32 * KB_;
constexpr size_t WS_WGT   = WS_CS + 256 * KB_;
constexpr size_t WS_Y2048 = 1536 * KB_;
constexpr size_t WS_WIN   = 2 * MB_;
constexpr size_t WS_WOUT  = WS_WIN + 5 * MB_;
constexpr size_t WS_WF    = WS_WOUT + 2 * MB_;
constexpr size_t WS_WFOLD = WS_WF + 2 * MB_;
constexpr size_t WS_WGU   = WS_WFOLD + 4 * MB_;
constexpr size_t WS_WD    = WS_WGU + 64 * MB_;
constexpr size_t WS_PART  = WS_WD + 16 * MB_;
constexpr size_t WS_H     = WS_WD + 32 * MB_;
constexpr size_t WS_LIST  = WS_H + 68 * MB_;
constexpr size_t WS_SLOTW = WS_LIST + 3 * MB_;
constexpr size_t WS_R     = WS_SLOTW + 6 * MB_;
constexpr size_t WS_SUM   = WS_R + 256 * MB_;
constexpr size_t WS_CAR   = WS_SUM + 9 * MB_;
constexpr size_t WS_MODP  = WS_CAR + 4 * MB_;
constexpr size_t WS_XA    = WS_SUM;
constexpr size_t WS_END   = WS_XA + 64 * MB_;
constexpr size_t R_Q = 0, R_K = 32 * MB_, R_VT = 64 * MB_, R_XB = 96 * MB_, R_GB = 128 * MB_, R_KC = 160 * MB_, R_VCT = 162 * MB_, R_XBC = 164 * MB_, R_MIX = 166 * MB_;
constexpr size_t R_T = 0, R_Y = 128 * MB_;
constexpr size_t R_P = 0;
constexpr size_t R_HID = 0;

struct P {
    const float *x, *c, *ctx, *c_ctx, *ada_w, *ada_b, *norm_mix, *norm_ffn, *mix_w_in, *mix_w_out, *qn, *kn, *rpb, *conv_w, *conv_b,
                *gr_w, *gr_b, *gi_w, *gi_b, *lam, *fnet_w, *router_w, *router_b, *wg, *wu, *wd;
    float* out; unsigned char* ws;
};

typedef __bf16 bf16v2_ __attribute__((ext_vector_type(2)));
typedef float f32v2_ __attribute__((ext_vector_type(2)));
DEV unsigned pk_bf16(float lo, float hi) { const f32v2_ v = {lo, hi}; const bf16v2_ b = __builtin_convertvector(v, bf16v2_); return __builtin_bit_cast(unsigned, b); }
DEV unsigned pk_bf16_asm(float lo, float hi) { unsigned r; asm("v_cvt_pk_bf16_f32 %0, %1, %2" : "=v"(r) : "v"(lo), "v"(hi)); return r; }
DEV bf16_t f2bf(float f) { return (bf16_t)(pk_bf16(f, 0.f) & 0xffffu); }
DEV float bf2f(bf16_t b) { return __uint_as_float(((unsigned)b) << 16); }
DEV float bflo(unsigned w) { return __uint_as_float(w << 16); }
DEV float bfhi(unsigned w) { return __uint_as_float(w & 0xffff0000u); }
DEV float sigmoidf_(float z) { return __builtin_amdgcn_rcpf(1.0f + __builtin_amdgcn_exp2f(-LOG2E * z)); }
DEV float gelu_tanh(float x) { const float u = 0.7978845608028654f * (x + 0.044715f * x * x * x); return x * __builtin_amdgcn_rcpf(1.0f + __builtin_amdgcn_exp2f(-2.0f * LOG2E * u)); }
DEV float clamp448(float v) { return fminf(fmaxf(v, -448.0f), 448.0f); }
DEV unsigned pk4_fp8(float a, float b, float c, float d) { unsigned w = 0u; w = (unsigned)__builtin_amdgcn_cvt_pk_fp8_f32(clamp448(a), clamp448(b), (int)w, false); w = (unsigned)__builtin_amdgcn_cvt_pk_fp8_f32(clamp448(c), clamp448(d), (int)w, true); return w; }
constexpr float F8_SH = 8.0f, F8_SW = 64.0f, F8_SHID = 8.0f;
constexpr float F8_SY = 0.0625f, F8_SWF = 32768.0f;
DEV unsigned pk2_fp8(float a, float b) { return (unsigned)__builtin_amdgcn_cvt_pk_fp8_f32(clamp448(a), clamp448(b), 0, false) & 0xffffu; }
DEV int clampi(int v, int lo, int hi) { return v < lo ? lo : (v > hi ? hi : v); }
DEV int l8row(int c) { return (c & ~31) + 16 * ((c >> 2) & 1) + 4 * ((c >> 3) & 3) + (c & 3); }
DEV int tid_() { int t = (int)threadIdx.x; asm volatile("" : "+v"(t)); return t; }

#define XB_TMO      128
#define XB_XCNT(j)  (256  + 64 * (j))
#define XB_XSUB(j)  (1280 + 64 * (j))
#define XB_XGEN(j)  (2304 + 64 * (j))
#define XB_TOP      3328
#define XB_TOPGEN   3392
#define XCD_BAR_WORDS 3456
#define XB_SPIN_CAP (1u << 22)
DEV unsigned xb_ld(unsigned* p)              { return __hip_atomic_load(p, __ATOMIC_RELAXED, __HIP_MEMORY_SCOPE_AGENT); }
DEV unsigned xb_add(unsigned* p, unsigned v) { return __hip_atomic_fetch_add(p, v, __ATOMIC_RELAXED, __HIP_MEMORY_SCOPE_AGENT); }
DEV unsigned xb_xcc_id() { return (unsigned)__builtin_amdgcn_s_getreg((3 << 11) | 20) & 0xFu; }
#define XB_SPIN(cond, bar) do { unsigned _sp = 0; while (cond) { __builtin_amdgcn_s_sleep(1); \
    if ((++_sp & 255u) == 0u) { if (xb_ld(&(bar)[XB_TMO])) break; if (_sp > XB_SPIN_CAP) { atomicAdd(&(bar)[XB_TMO], 1u); break; } } } } while (0)
struct XcdBarrier { unsigned* bar; unsigned x; volatile LAS unsigned* st; };
DEV XcdBarrier xcd_barrier_post(unsigned* bar, volatile LAS unsigned* st) {
    XcdBarrier b; b.bar = bar; b.x = xb_xcc_id(); b.st = st;
    if (threadIdx.x == 0) (void)xb_add(&bar[XB_XCNT(b.x)], 1u);
    return b;
}
DEV void xcd_barrier_complete(unsigned* bar, unsigned x, unsigned& nloc, unsigned& nx) {
    const unsigned G = gridDim.x * gridDim.y * gridDim.z;
    unsigned sum, cnt, mine, sp = 0u;
    for (;;) {
        sum = 0u; cnt = 0u; mine = 0u;
#pragma unroll
        for (unsigned j = 0; j < 16; ++j) { const unsigned c = xb_ld(&bar[XB_XCNT(j)]); sum += c; cnt += (c > 0u) ? 1u : 0u; mine = (j == x) ? c : mine; }
        if (sum == G) break;
        __builtin_amdgcn_s_sleep(1);
        if ((++sp & 255u) == 0u) { if (xb_ld(&bar[XB_TMO])) break; if (sp > XB_SPIN_CAP) { atomicAdd(&bar[XB_TMO], 1u); break; } }
    }
    nloc = mine > 0u ? mine : 1u; nx = cnt > 0u ? cnt : 1u;
}
DEV void xcd_barrier(const XcdBarrier& b) {
    asm volatile("s_waitcnt vmcnt(0)" ::: "memory");
    __syncthreads();
    if (threadIdx.x == 0) {
        unsigned* bar = b.bar;
        __builtin_amdgcn_s_waitcnt(0);
        unsigned nloc = b.st[0], nx = b.st[1];
        if (nloc == 0u) { xcd_barrier_complete(bar, b.x, nloc, nx); b.st[0] = nloc; b.st[1] = nx; }
        const unsigned old = xb_add(&bar[XB_XSUB(b.x)], 1u);
        const unsigned gen = old / nloc;
        if (old + 1u == (gen + 1u) * nloc) {
            __builtin_amdgcn_fence(__ATOMIC_RELEASE, "agent");
            asm volatile("s_waitcnt vmcnt(0)" ::: "memory");
            const unsigned og = xb_add(&bar[XB_TOP], 1u);
            const unsigned tg = og / nx;
            if (og + 1u == (tg + 1u) * nx) xb_add(&bar[XB_TOPGEN], 1u);
            else XB_SPIN(xb_ld(&bar[XB_TOPGEN]) == tg, bar);
            __builtin_amdgcn_fence(__ATOMIC_ACQUIRE, "agent");
            xb_add(&bar[XB_XGEN(b.x)], 1u);
            asm volatile("s_waitcnt vmcnt(0)" ::: "memory");
        } else {
            XB_SPIN(xb_ld(&bar[XB_XGEN(b.x)]) == gen, bar);
            __builtin_amdgcn_fence(__ATOMIC_ACQUIRE, "agent");
            asm volatile("s_waitcnt vmcnt(0)" ::: "memory");
        }
    }
    __syncthreads();
}

namespace g8 {
constexpr int BM = 256, BK = 64, HALF = 128, HTB = HALF * BK * 2, STAGE_BYTES = 8 * HTB;
DEV int lds_byte(int r, int c) { const int st = (r >> 4) * 2 + (c >> 5), rr = r & 15, cc = c & 31, ob = rr * 64 + cc * 2; return st * 1024 + (ob ^ (((ob >> 9) & 1) << 5)); }
DEV void stage_rc(int b, int& R, int& C) { const int st = b / 1024, sb = b % 1024, swz = sb ^ (((sb >> 9) & 1) << 5); R = (st >> 1) * 16 + swz / 64; C = (st & 1) * 32 + (swz % 64) / 2; }

struct UCtx {
    const char* A; const char* B0; const char* B1;
    unsigned aoff[2][2];
    int i0, i1, i2, i3, i4;
    int swap;
};

template <class Job>
DEV void gemm_phase(LAS unsigned char* lds, const Job& J) {
    const int tid = tid_(), wid = __builtin_amdgcn_readfirstlane(tid >> 6), lane = tid & 63, wr = wid >> 2, wc = wid & 3, fr = lane & 15, fq = lane >> 4;
    constexpr int ESZ = Job::FP8 ? 1 : 2;
    constexpr int K = Job::K, nt = K * ESZ / 128, KSPLIT = Job::KSPLIT, LDB = Job::LDB;
    int Rr[2], Cc[2]; unsigned voffB[2];
#pragma unroll
    for (int i = 0; i < 2; ++i) { int R, C; stage_rc(tid * 16 + i * 8192, R, C); Rr[i] = R; Cc[i] = C; voffB[i] = (unsigned)(R * LDB * ESZ + C * 2); }
    constexpr size_t kstep = (size_t)(BK * 2);
    constexpr size_t hstepB = (size_t)HALF * LDB * ESZ;
    const unsigned ldsw = (unsigned)wid * 1024u;
    const int aoff = lds_byte(wr * 64 + fr, fq * 8), boff = lds_byte(wc * 32 + fr, fq * 8);
#define G8_SA(b, h) (((b) * 2 + (h)) * HTB)
#define G8_SB(b, h) ((4 + (b) * 2 + (h)) * HTB)
#define G8_STAGE_A(bufoff, cx, h, tb) do { _Pragma("unroll") for (int _i = 0; _i < 2; ++_i) \
        __builtin_amdgcn_raw_ptr_buffer_load_lds(rsrcA, (LAS unsigned*)(lds + (bufoff) + ldsw + _i * 8192), 16, (int)(cx).aoff[h][_i], (int)(tb), 0, 0); } while (0)
#define G8_STAGE_B(bufoff, bp, h) do { _Pragma("unroll") for (int _i = 0; _i < 2; ++_i) \
        __builtin_amdgcn_raw_ptr_buffer_load_lds(rsrcB, (LAS unsigned*)(lds + (bufoff) + ldsw + _i * 8192), 16, (int)voffB[_i], (int)((unsigned)((bp) - bbase) + (unsigned)((h) * hstepB)), 0, 0); } while (0)
#define G8_BT(cx, t) (((t) < KSPLIT) ? (cx).B0 + (size_t)(t) * kstep : (cx).B1 + (size_t)((t) - KSPLIT) * kstep)
#define G8_LDA(dst, b, h) do { if constexpr (Job::FP8) { _Pragma("unroll") for (int m = 0; m < 4; ++m) { const i32x4 lo_ = *(const LAS i32x4*)(lds + G8_SA(b, h) + aoff + m * 2048), hi_ = *(const LAS i32x4*)(lds + G8_SA(b, h) + aoff + m * 2048 + 1024); \
            dst##8[m] = __builtin_shufflevector(lo_, hi_, 0, 1, 2, 3, 4, 5, 6, 7); } } \
        else { _Pragma("unroll") for (int m = 0; m < 4; ++m) _Pragma("unroll") for (int k = 0; k < 2; ++k) dst[m][k] = *(const LAS bf16x8*)(lds + G8_SA(b, h) + aoff + m * 2048 + k * 1024); } } while (0)
#define G8_LDB(dst, b, h) do { if constexpr (Job::FP8) { _Pragma("unroll") for (int n = 0; n < 2; ++n) { const i32x4 lo_ = *(const LAS i32x4*)(lds + G8_SB(b, h) + boff + n * 2048), hi_ = *(const LAS i32x4*)(lds + G8_SB(b, h) + boff + n * 2048 + 1024); \
            dst##8[n] = __builtin_shufflevector(lo_, hi_, 0, 1, 2, 3, 4, 5, 6, 7); } } \
        else { _Pragma("unroll") for (int n = 0; n < 2; ++n) _Pragma("unroll") for (int k = 0; k < 2; ++k) dst[n][k] = *(const LAS bf16x8*)(lds + G8_SB(b, h) + boff + n * 2048 + k * 1024); } } while (0)
#define G8_MMA(ai, bj, At, Bt) do { __builtin_amdgcn_s_setprio(1); \
        if constexpr (Job::FP8) { _Pragma("unroll") for (int m = 0; m < 4; ++m) _Pragma("unroll") for (int n = 0; n < 2; ++n) \
            { if constexpr (Job::SWAPPED) asm volatile("v_mfma_f32_16x16x128_f8f6f4 %0, %1, %2, %0" : "+v"(acc[ai][bj][m][n]) : "v"(At##8[m]), "v"(Bt##8[n])); \
              else asm volatile("v_mfma_f32_16x16x128_f8f6f4 %0, %1, %2, %0" : "+v"(acc[ai][bj][m][n]) : "v"(Bt##8[n]), "v"(At##8[m])); } } \
        else if constexpr (Job::SWAPPED) { _Pragma("unroll") for (int m = 0; m < 4; ++m) _Pragma("unroll") for (int n = 0; n < 2; ++n) _Pragma("unroll") for (int k = 0; k < 2; ++k) \
            acc[ai][bj][m][n] = __builtin_amdgcn_mfma_f32_16x16x32_bf16(At[m][k], Bt[n][k], acc[ai][bj][m][n], 0, 0, 0); } \
        else { _Pragma("unroll") for (int m = 0; m < 4; ++m) _Pragma("unroll") for (int n = 0; n < 2; ++n) _Pragma("unroll") for (int k = 0; k < 2; ++k) \
            acc[ai][bj][m][n] = __builtin_amdgcn_mfma_f32_16x16x32_bf16(Bt[n][k], At[m][k], acc[ai][bj][m][n], 0, 0, 0); } \
        __builtin_amdgcn_s_setprio(0); } while (0)
#define G8_WAIT_V(n) asm volatile("s_waitcnt vmcnt(" #n ")" ::: "memory")
#define G8_WAIT_L(n) asm volatile("s_waitcnt lgkmcnt(" #n ")" ::: "memory")
#define G8_BAR __builtin_amdgcn_s_barrier()
#define G8_SCHED __builtin_amdgcn_sched_barrier(0)
    UCtx cur, nxt; int ui = 0; unsigned* pend = nullptr;
    if (!J.get(0, cur, Rr, Cc)) return;
#define G8_DEPWAIT(cx) do { if constexpr (Job::SYNC == 2) { if (tid == 0) { unsigned* tc_ = J.tile_counter(cx); unsigned sp_ = 0; while (xb_ld(tc_) < 8u && ++sp_ < XB_SPIN_CAP) __builtin_amdgcn_s_sleep(2); \
            __builtin_amdgcn_fence(__ATOMIC_ACQUIRE, "agent"); } __syncthreads(); } } while (0)
    G8_DEPWAIT(cur);
    const char* const bbase = J.bbase();
    const __amdgpu_buffer_rsrc_t rsrcA = __builtin_amdgcn_make_buffer_rsrc((void*)cur.A, 0, 0x7fffffff, 0x00020000);
    const __amdgpu_buffer_rsrc_t rsrcB = __builtin_amdgcn_make_buffer_rsrc((void*)bbase, 0, 0x7fffffff, 0x00020000);
    f32x4 acc[2][2][4][2];
#pragma unroll
    for (int a = 0; a < 2; ++a)
#pragma unroll
        for (int b = 0; b < 2; ++b)
#pragma unroll
            for (int m = 0; m < 4; ++m)
#pragma unroll
                for (int n = 0; n < 2; ++n) acc[a][b][m][n] = (f32x4){0.f, 0.f, 0.f, 0.f};
    bf16x8 At[4][2], B0[2][2], B1[2][2];
    i32x8 At8[4], B08[2], B18[2];
    { const char* b0 = G8_BT(cur, 0); const char* b1 = G8_BT(cur, 1);
      G8_STAGE_B(G8_SB(0, 0), b0, 0); G8_STAGE_B(G8_SB(0, 1), b0, 1); G8_STAGE_A(G8_SA(0, 0), cur, 0, 0); G8_STAGE_A(G8_SA(0, 1), cur, 1, 0);
      if (wr == 1) G8_BAR;
      G8_WAIT_V(2); G8_BAR;
      G8_STAGE_B(G8_SB(1, 0), b1, 0); G8_STAGE_A(G8_SA(1, 0), cur, 0, kstep); G8_STAGE_B(G8_SB(1, 1), b1, 1);
      G8_WAIT_V(6); G8_BAR; }
    for (;;) {
        const bool has_next = J.get(ui + 1, nxt, Rr, Cc);
        if (has_next) G8_DEPWAIT(nxt);
        if (!has_next) { nxt.A = cur.A; nxt.B0 = cur.B0; nxt.B1 = cur.B1; nxt.aoff[0][0] = cur.aoff[0][0]; nxt.aoff[0][1] = cur.aoff[0][1]; nxt.aoff[1][0] = cur.aoff[1][0]; nxt.aoff[1][1] = cur.aoff[1][1]; }
        for (int t = 0; t < nt; t += 2) {
            const bool last = (t == nt - 2);
            const int t2 = last ? 0 : t + 2, t3 = last ? 1 : t + 3;
            const char* b2 = last ? G8_BT(nxt, t2) : G8_BT(cur, t2); const char* b3 = last ? G8_BT(nxt, t3) : G8_BT(cur, t3);
            struct { const char* A; unsigned aoff[2][2]; } c2;
            c2.A = last ? nxt.A : cur.A;
            c2.aoff[0][0] = last ? nxt.aoff[0][0] : cur.aoff[0][0]; c2.aoff[0][1] = last ? nxt.aoff[0][1] : cur.aoff[0][1];
            c2.aoff[1][0] = last ? nxt.aoff[1][0] : cur.aoff[1][0]; c2.aoff[1][1] = last ? nxt.aoff[1][1] : cur.aoff[1][1];
            const size_t a1b = (size_t)(t + 1) * kstep, a2b = (size_t)t2 * kstep, a3b = (size_t)t3 * kstep;
            G8_LDB(B0, 0, 0); G8_LDB(B1, 0, 1); G8_SCHED; G8_LDA(At, 0, 0); G8_STAGE_A(G8_SA(1, 1), cur, 1, a1b);
            G8_WAIT_V(8); G8_WAIT_L(0); G8_BAR; G8_MMA(0, 0, At, B0); G8_MMA(0, 1, At, B1); G8_BAR; G8_SCHED;
            G8_LDA(At, 0, 1); G8_STAGE_B(G8_SB(0, 0), b2, 0); G8_STAGE_B(G8_SB(0, 1), b2, 1); G8_STAGE_A(G8_SA(0, 0), c2, 0, a2b);
            G8_WAIT_V(8); G8_WAIT_L(0); G8_BAR; G8_MMA(1, 0, At, B0); G8_MMA(1, 1, At, B1); G8_BAR; G8_SCHED;
            G8_LDB(B0, 1, 0); G8_LDB(B1, 1, 1); G8_SCHED; G8_LDA(At, 1, 0); G8_STAGE_A(G8_SA(0, 1), c2, 1, a2b);
            G8_WAIT_V(8); G8_WAIT_L(0); G8_BAR; G8_MMA(0, 0, At, B0); G8_MMA(0, 1, At, B1); G8_BAR; G8_SCHED;
            G8_LDA(At, 1, 1); G8_STAGE_B(G8_SB(1, 0), b3, 0); G8_STAGE_B(G8_SB(1, 1), b3, 1); G8_STAGE_A(G8_SA(1, 0), c2, 0, a3b);
            G8_WAIT_V(8); G8_WAIT_L(0); G8_BAR; G8_MMA(1, 0, At, B0); G8_MMA(1, 1, At, B1); G8_BAR; G8_SCHED;
        }
        if (wr == 0) G8_BAR;
        if constexpr (Job::FP8) asm volatile("s_nop 15\n\ts_nop 7" ::: "memory");
        if constexpr (Job::SYNC == 1) {
            if (pend != nullptr && tid == 0) (void)xb_add(pend, 1u);
        }
        J.epi(acc, cur, wr, wc, fr, fq);
        if constexpr (Job::SYNC == 1) {
            if (has_next) pend = J.tile_counter(cur);
            else { asm volatile("s_waitcnt vmcnt(0)" ::: "memory"); __syncthreads(); if (tid == 0) (void)xb_add(J.tile_counter(cur), 1u); }
        }
        if (!has_next) break;
#pragma unroll
        for (int a = 0; a < 2; ++a)
#pragma unroll
            for (int b = 0; b < 2; ++b)
#pragma unroll
                for (int m = 0; m < 4; ++m)
#pragma unroll
                    for (int n = 0; n < 2; ++n) acc[a][b][m][n] = (f32x4){0.f, 0.f, 0.f, 0.f};
        cur.A = nxt.A; cur.B0 = nxt.B0; cur.B1 = nxt.B1; cur.aoff[0][0] = nxt.aoff[0][0]; cur.aoff[0][1] = nxt.aoff[0][1]; cur.aoff[1][0] = nxt.aoff[1][0]; cur.aoff[1][1] = nxt.aoff[1][1];
        cur.i0 = nxt.i0; cur.i1 = nxt.i1; cur.i2 = nxt.i2; cur.i3 = nxt.i3; cur.i4 = nxt.i4; cur.swap = nxt.swap; ++ui;
        if (wr == 1) G8_BAR;
    }
    G8_WAIT_V(0);
    G8_BAR;
#undef G8_DEPWAIT
#undef G8_SA
#undef G8_SB
#undef G8_STAGE_A
#undef G8_STAGE_B
#undef G8_BT
#undef G8_LDA
#undef G8_LDB
#undef G8_MMA
#undef G8_WAIT_V
#undef G8_WAIT_L
#undef G8_BAR
#undef G8_SCHED
}
}
using g8::UCtx;

DEV bool deal(int i, int nPanels, int nN, int& pm, int& pn, bool rev = false) {
    const int G = (int)gridDim.x, bid = (int)blockIdx.x;
    if ((G & 7) == 0) {
        const int x = bid & 7, W = G >> 3, w = rev ? W - 1 - (bid >> 3) : (bid >> 3);
        const int v = w + W * i, j = v / nN; pn = v - j * nN; pm = x + 8 * j;
        return pm < nPanels;
    } else {
        const int v = (rev ? G - 1 - bid : bid) + G * i; pm = v / nN; pn = v - pm * nN; return pm < nPanels;
    }
}

constexpr int CTX_D0 = 32;
template <bool VT, bool F8>
struct JobInProj {
    static constexpr int K = 1024, LDB = 1024, KSPLIT = F8 ? 8 : 16, SWAPPED = VT ? 1 : 0, FP8 = F8 ? 1 : 0; static constexpr int SYNC = 0;
    P p; int mode;
    DEV const char* bbase() const { return (const char*)(p.ws + WS_WIN) + (F8 ? 0 : 2 * MB_); }
    DEV bool get(int i, UCtx& c, const int (&Rr)[2], const int (&Cc)[2]) const {
        const int G = (int)gridDim.x, bid = (int)blockIdx.x; int pm, pn;
        const int x = bid & 7, W = G >> 3;
        if (mode == 2) { if (i) return false; pm = 128 + x; pn = 2 + ((bid - CTX_D0) >> 3); }
        else if constexpr (!VT && F8) {
            const int w = bid >> 3, v = w + W * i;
            if (v < 64) { pm = x + 8 * (v >> 2); pn = v & 3; }
            else if (v < 66 && mode == 0) { pm = 128 + x; pn = 2 + (v - 64); }
            else return false;
        } else if constexpr (VT) {
            const int w = W - 1 - (bid >> 3), v = w + W * i;
            if (v < 32) { pm = x + 8 * (v >> 1); pn = 4 + (v & 1); }
            else if (v < 34 && mode == 0) { pm = 128 + x; pn = 4 + (v - 32); }
            else return false;
        } else {
            const int w = ((bid >> 3) + (W >> 1)) % W, v = w + W * i;
            if (v < 64) { pm = x + 8 * (v >> 2); pn = 6 + (v & 3); }
            else if (v < 66 && mode == 0) { pm = 128 + x; pn = 6 + (v - 64); }
            else return false;
        }
        if constexpr (F8) { c.A = (const char*)p.out; c.B0 = (const char*)(p.ws + WS_WIN) + (size_t)(256 * pn) * LDB; }
        else { c.A = (const char*)(p.ws + WS_H); c.B0 = (const char*)(p.ws + WS_WIN) + 2 * MB_ + (size_t)(256 * (pn - 6)) * LDB * 2; }
        c.B1 = c.B0;
#pragma unroll
        for (int h = 0; h < 2; ++h)
#pragma unroll
            for (int k = 0; k < 2; ++k) c.aoff[h][k] = F8 ? (unsigned)((256 * pm + 128 * h + Rr[k]) * K + Cc[k] * 2) : (unsigned)((256 * pm + 128 * h + Rr[k]) * K + Cc[k]) * 2u;
        c.i0 = pm; c.i1 = pn; c.i2 = 0; c.i3 = 0; c.i4 = 0; c.swap = (pn == 4 || pn == 5) ? 1 : 0;
        return true;
    }
    DEV void epi(const f32x4 (&acc)[2][2][4][2], const UCtx& c, int wr, int wc, int fr, int fq) const {
        constexpr float ISC = F8 ? 1.0f / (F8_SH * F8_SW) : 1.0f;
        const int pm = c.i0, pn = c.i1; const bool isctx = pm >= 128;
        unsigned char* R = p.ws + WS_R;
        const int rowbase = isctx ? (256 * pm - MTOK) : 256 * pm;
        if constexpr (!VT) { if constexpr (F8) {
            const bool isq = pn < 2; const int head = 4 * (pn & 1) + wc;
            const float* gn = isq ? p.qn : p.kn; const float osc = isq ? 0.125f * LOG2E : 1.0f;
            f32x4 g[2][2];
#pragma unroll
            for (int bj = 0; bj < 2; ++bj)
#pragma unroll
                for (int n = 0; n < 2; ++n) g[bj][n] = *(const f32x4*)(gn + 32 * bj + 8 * fq + 4 * n);
            bf16_t* dst = (bf16_t*)(R + (isq ? R_Q : (isctx ? R_KC : R_K)));
#pragma unroll
            for (int ai = 0; ai < 2; ++ai)
#pragma unroll
                for (int m = 0; m < 4; ++m) {
                    float ss = 0.f;
#pragma unroll
                    for (int bj = 0; bj < 2; ++bj)
#pragma unroll
                        for (int n = 0; n < 2; ++n) { const f32x4 v = acc[ai][bj][m][n]; ss += v[0] * v[0] + v[1] * v[1] + v[2] * v[2] + v[3] * v[3]; }
                    ss += __shfl_xor(ss, 16); ss += __shfl_xor(ss, 32);
                    const float rs = rsqrtf(ss * (ISC * ISC / 64.0f) + 1e-6f) * osc * ISC;
                    const int row = rowbase + 128 * ai + 64 * wr + 16 * m + fr;
#pragma unroll
                    for (int bj = 0; bj < 2; ++bj) {
                        const f32x4 v0 = acc[ai][bj][m][0] * rs * g[bj][0], v1 = acc[ai][bj][m][1] * rs * g[bj][1];
                        u32x4 w; w.x = pk_bf16(v0[0], v0[1]); w.y = pk_bf16(v0[2], v0[3]); w.z = pk_bf16(v1[0], v1[1]); w.w = pk_bf16(v1[2], v1[3]);
                        *(u32x4*)(dst + (size_t)row * 512 + head * 64 + 32 * bj + 8 * fq) = w;
                    }
                }
        } else {
            const bool gel = pn >= 8; const int colbase = 256 * ((pn - 6) & 1) + 64 * wc;
            bf16_t* dst = (bf16_t*)(R + (gel ? R_GB : (isctx ? R_XBC : R_XB)));
#pragma unroll
            for (int ai = 0; ai < 2; ++ai)
#pragma unroll
                for (int m = 0; m < 4; ++m) {
                    const int row = rowbase + 128 * ai + 64 * wr + 16 * m + fr;
#pragma unroll
                    for (int bj = 0; bj < 2; ++bj) {
                        f32x4 v0 = acc[ai][bj][m][0], v1 = acc[ai][bj][m][1];
                        if (gel) {
#pragma unroll
                            for (int q = 0; q < 4; ++q) { v0[q] = gelu_tanh(v0[q]); v1[q] = gelu_tanh(v1[q]); }
                        }
                        u32x4 w; w.x = pk_bf16(v0[0], v0[1]); w.y = pk_bf16(v0[2], v0[3]); w.z = pk_bf16(v1[0], v1[1]); w.w = pk_bf16(v1[2], v1[3]);
                        *(u32x4*)(dst + (size_t)row * 512 + colbase + 32 * bj + 8 * fq) = w;
                    }
                }
        } } else {
            const int head = 4 * (pn - 4) + wc;
            bf16_t* dst = (bf16_t*)(R + (isctx ? R_VCT : R_VT));
            const int tshift = isctx ? 8 : 12, tlen = isctx ? CTXL : SEQ;
#pragma unroll
            for (int ai = 0; ai < 2; ++ai)
#pragma unroll
                for (int m = 0; m < 4; ++m) {
                    const int tok = rowbase + 128 * ai + 64 * wr + 16 * m + 4 * fq;
                    const int b = tok >> tshift, nn = tok & (tlen - 1);
#pragma unroll
                    for (int bj = 0; bj < 2; ++bj)
#pragma unroll
                        for (int n = 0; n < 2; ++n) {
                            const int d = 32 * bj + 8 * (fr >> 2) + 4 * n + (fr & 3);
                            const f32x4 v = acc[ai][bj][m][n] * ISC;
                            u32x2 w; w.x = pk_bf16(v[0], v[1]); w.y = pk_bf16(v[2], v[3]);
                            *(u32x2*)(dst + ((size_t)((b * 8 + head) * 64 + d)) * tlen + nn) = w;
                        }
                }
        }
    }
};

template <int KK, bool BASE_BF16>
struct JobResid {
    static constexpr int K = KK, LDB = KK, KSPLIT = KK / 64, SWAPPED = 0, FP8 = 0; static constexpr int SYNC = 0;
    const bf16_t* A; const bf16_t* Bt; const void* base; bf16_t* out; const float* gate;
    DEV const char* bbase() const { return (const char*)Bt; }
    DEV bool get(int i, UCtx& c, const int (&Rr)[2], const int (&Cc)[2]) const {
        int pm, pn; if (!deal(i, 128, 4, pm, pn)) return false;
        c.A = (const char*)A; c.B0 = (const char*)Bt + (size_t)(256 * pn) * LDB * 2; c.B1 = c.B0;
#pragma unroll
        for (int h = 0; h < 2; ++h)
#pragma unroll
            for (int k = 0; k < 2; ++k) c.aoff[h][k] = (unsigned)((256 * pm + 128 * h + Rr[k]) * K + Cc[k]) * 2u;
        c.i0 = pm; c.i1 = pn; c.i2 = 0; c.i3 = 0; c.i4 = 0; c.swap = 0; return true;
    }
    DEV void epi(const f32x4 (&acc)[2][2][4][2], const UCtx& c, int wr, int wc, int fr, int fq) const {
        const int pm = c.i0, pn = c.i1; const int b = pm >> 4;
        const int col0 = 256 * pn + 32 * wc + 8 * fq;
        f32x4 gv[2][2];
#pragma unroll
        for (int bj = 0; bj < 2; ++bj)
#pragma unroll
            for (int n = 0; n < 2; ++n) gv[bj][n] = *(const f32x4*)(gate + (size_t)b * 6144 + col0 + 128 * bj + 4 * n);
#pragma unroll
        for (int ai = 0; ai < 2; ++ai)
#pragma unroll
        for (int mp = 0; mp < 2; ++mp) {
            f32x4 bs[2][2][2];
#pragma unroll
            for (int mm = 0; mm < 2; ++mm) { const size_t off = (size_t)(256 * pm + 128 * ai + 64 * wr + 16 * (2 * mp + mm) + fr) * DM + col0;
#pragma unroll
                for (int bj = 0; bj < 2; ++bj) {
                    if constexpr (BASE_BF16) { const u32x4 w = *(const u32x4*)((const bf16_t*)base + off + 128 * bj); bs[mm][bj][0] = (f32x4){bflo(w.x), bfhi(w.x), bflo(w.y), bfhi(w.y)}; bs[mm][bj][1] = (f32x4){bflo(w.z), bfhi(w.z), bflo(w.w), bfhi(w.w)}; }
                    else { bs[mm][bj][0] = *(const f32x4*)((const float*)base + off + 128 * bj); bs[mm][bj][1] = *(const f32x4*)((const float*)base + off + 128 * bj + 4); } } }
#pragma unroll
            for (int mm = 0; mm < 2; ++mm) { const int m = 2 * mp + mm; const size_t off = (size_t)(256 * pm + 128 * ai + 64 * wr + 16 * m + fr) * DM + col0;
#pragma unroll
                for (int bj = 0; bj < 2; ++bj) { const f32x4 v0 = bs[mm][bj][0] + gv[bj][0] * acc[ai][bj][m][0], v1 = bs[mm][bj][1] + gv[bj][1] * acc[ai][bj][m][1];
                    u32x4 w; w.x = pk_bf16(v0[0], v0[1]); w.y = pk_bf16(v0[2], v0[3]); w.z = pk_bf16(v1[0], v1[1]); w.w = pk_bf16(v1[2], v1[3]); *(u32x4*)(out + off + 128 * bj) = w; } }
        }
    }
};

template <int PART>
struct JobHerm {
    static constexpr int K = 1024, LDB = 2048, KSPLIT = 8, SWAPPED = 0, FP8 = 1; static constexpr int SYNC = 0;
    P p; bf16_t* xa;
    DEV const char* bbase() const { return (const char*)(p.ws + WS_WFOLD); }
    DEV bool get(int i, UCtx& c, const int (&Rr)[2], const int (&Cc)[2]) const {
        int pm, pn; if (!deal(i, 64, 4, pm, pn)) return false;
        c.A = (const char*)(p.ws + WS_R + R_Y) + PART * 1024; c.B0 = (const char*)(p.ws + WS_WFOLD) + ((size_t)(256 * pn) * LDB + PART * 1024); c.B1 = c.B0;
#pragma unroll
        for (int h = 0; h < 2; ++h)
#pragma unroll
            for (int k = 0; k < 2; ++k) c.aoff[h][k] = (unsigned)((256 * pm + 128 * h + Rr[k]) * 2048 + Cc[k] * 2);
        c.i0 = pm; c.i1 = pn; c.i2 = 0; c.i3 = 0; c.i4 = 0; c.swap = 0; return true;
    }
    DEV void epi(const f32x4 (&acc)[2][2][4][2], const UCtx& c, int wr, int wc, int fr, int fq) const {
        constexpr float ISC = 1.0f / (F8_SY * F8_SWF);
        const int pm = c.i0, pn = c.i1; const int b = pm >> 3;
        const int col0 = 256 * pn + 32 * wc + 8 * fq;
        bf16_t* Pb = (bf16_t*)(p.ws + WS_R + R_P);
        if constexpr (PART == 0) {
#pragma unroll
            for (int ai = 0; ai < 2; ++ai)
#pragma unroll
                for (int m = 0; m < 4; ++m) { const size_t off = (size_t)(256 * pm + 128 * ai + 64 * wr + 16 * m + fr) * DM + col0;
#pragma unroll
                    for (int bj = 0; bj < 2; ++bj) { const f32x4 v0 = acc[ai][bj][m][0] * ISC, v1 = acc[ai][bj][m][1] * ISC;
                        u32x4 w; w.x = pk_bf16(v0[0], v0[1]); w.y = pk_bf16(v0[2], v0[3]); w.z = pk_bf16(v1[0], v1[1]); w.w = pk_bf16(v1[2], v1[3]); *(u32x4*)(Pb + off + 128 * bj) = w; } }
        } else {
            const float* gate = (const float*)(p.ws + WS_MOD) + (size_t)9 * 6144 + 2048 + (size_t)b * 6144 + col0;
            f32x4 gv[2][2];
#pragma unroll
            for (int bj = 0; bj < 2; ++bj)
#pragma unroll
                for (int n = 0; n < 2; ++n) gv[bj][n] = *(const f32x4*)(gate + 128 * bj + 4 * n);
#pragma unroll
            for (int ai = 0; ai < 2; ++ai)
#pragma unroll
                for (int m = 0; m < 4; ++m) {
                    const int prow = 256 * pm + 128 * ai + 64 * wr + 16 * m + fr, kk = prow & 2047;
                    const size_t poff = (size_t)prow * DM + col0;
                    const size_t o1 = ((size_t)b * SEQ + kk) * DM + col0, o2 = ((size_t)b * SEQ + ((SEQ - kk) & (SEQ - 1))) * DM + col0;
                    u32x4 pw[2], x1[2], x2[2];
#pragma unroll
                    for (int bj = 0; bj < 2; ++bj) { pw[bj] = *(const u32x4*)(Pb + poff + 128 * bj); x1[bj] = *(const u32x4*)(xa + o1 + 128 * bj); x2[bj] = *(const u32x4*)(xa + o2 + 128 * bj); }
#pragma unroll
                    for (int bj = 0; bj < 2; ++bj) {
                        const unsigned pwv[4] = {pw[bj].x, pw[bj].y, pw[bj].z, pw[bj].w}, x1v[4] = {x1[bj].x, x1[bj].y, x1[bj].z, x1[bj].w}, x2v[4] = {x2[bj].x, x2[bj].y, x2[bj].z, x2[bj].w};
                        unsigned r1[4], r2[4];
#pragma unroll
                        for (int q = 0; q < 4; ++q) {
                            const float g0 = gv[bj][q >> 1][2 * (q & 1)], g1 = gv[bj][q >> 1][2 * (q & 1) + 1];
                            const float q0 = acc[ai][bj][m][q >> 1][2 * (q & 1)] * ISC, q1 = acc[ai][bj][m][q >> 1][2 * (q & 1) + 1] * ISC;
                            const float p0 = bflo(pwv[q]), p1 = bfhi(pwv[q]);
                            r1[q] = pk_bf16(bflo(x1v[q]) + g0 * (p0 + q0), bfhi(x1v[q]) + g1 * (p1 + q1));
                            r2[q] = pk_bf16(bflo(x2v[q]) + g0 * (p0 - q0), bfhi(x2v[q]) + g1 * (p1 - q1));
                        }
                        *(u32x4*)(xa + o1 + 128 * bj) = (u32x4){r1[0], r1[1], r1[2], r1[3]};
                        if (kk != 0) *(u32x4*)(xa + o2 + 128 * bj) = (u32x4){r2[0], r2[1], r2[2], r2[3]};
                    }
                }
        }
    }
};
DEV void phase_herm_row2048(const P& p, LAS unsigned char* lds, bf16_t* xa) {
    const int tid = tid_(), bid = (int)blockIdx.x;
    if (bid >= 64) return;
    const int b = bid >> 3, o = 128 * (bid & 7) + (tid & 127), kq = tid >> 7;
    const float* y = (const float*)(p.ws + WS_Y2048) + b * 1024 + 256 * kq;
    const unsigned char* w = p.ws + WS_WFOLD + (size_t)l8row(o) * 2048 + 256 * kq;
    float a = 0.f;
#pragma unroll 4
    for (int k = 0; k < 256; k += 8) { const u32x2 ww = *(const u32x2*)(w + k); const f32x4 y0 = *(const f32x4*)(y + k), y1 = *(const f32x4*)(y + k + 4);
        const f32v2_ w01 = __builtin_amdgcn_cvt_pk_f32_fp8((int)ww.x, false), w23 = __builtin_amdgcn_cvt_pk_f32_fp8((int)ww.x, true), w45 = __builtin_amdgcn_cvt_pk_f32_fp8((int)ww.y, false), w67 = __builtin_amdgcn_cvt_pk_f32_fp8((int)ww.y, true);
        a += y0[0] * w01[0] + y0[1] * w01[1] + y0[2] * w23[0] + y0[3] * w23[1] + y1[0] * w45[0] + y1[1] * w45[1] + y1[2] * w67[0] + y1[3] * w67[1]; }
    a *= (1.0f / F8_SWF);
    LAS float* red = (LAS float*)lds;
    red[tid] = a; __syncthreads();
    if (tid < 128) { const float tot = (red[tid] + red[tid + 128]) + (red[tid + 256] + red[tid + 384]);
        const float g = ((const float*)(p.ws + WS_MOD))[(size_t)9 * 6144 + (size_t)b * 6144 + 2048 + o];
        bf16_t* x = xa + ((size_t)b * SEQ + 2048) * DM + o; *x = f2bf(bf2f(*x) + g * tot); }
    __syncthreads();
}

struct JobFold {
    static constexpr int K = 256, LDB = 256, KSPLIT = 4, SWAPPED = 0, FP8 = 0; static constexpr int SYNC = 0;
    P p;
    DEV const char* bbase() const { return (const char*)(p.ws + WS_CS); }
    DEV bool get(int i, UCtx& c, const int (&Rr)[2], const int (&Cc)[2]) const {
        const int u = (int)blockIdx.x; if (i != 0 || u >= 32) return false;
        const int g = u >> 3, pm = (u >> 1) & 3, pn = u & 1;
        c.A = (const char*)(p.ws + WS_WF); c.B0 = (const char*)(p.ws + WS_CS) + (size_t)(256 * pn) * LDB * 2; c.B1 = c.B0;
#pragma unroll
        for (int h = 0; h < 2; ++h)
#pragma unroll
            for (int k = 0; k < 2; ++k) c.aoff[h][k] = (unsigned)((256 * pm + 128 * h + Rr[k]) * 1024 + g * 256 + Cc[k]) * 2u;
        c.i0 = pm; c.i1 = pn; c.i2 = g; c.i3 = 0; c.i4 = 0; c.swap = 0; return true;
    }
    DEV void epi(const f32x4 (&acc)[2][2][4][2], const UCtx& c, int wr, int wc, int fr, int fq) const {
        unsigned char* W = p.ws + WS_WFOLD;
        const int pm = c.i0, pn = c.i1, g = c.i2;
#pragma unroll
        for (int ai = 0; ai < 2; ++ai)
#pragma unroll
            for (int m = 0; m < 4; ++m) {
                const int o = l8row(256 * pm + 128 * ai + 64 * wr + 16 * m + fr);
#pragma unroll
                for (int bj = 0; bj < 2; ++bj)
#pragma unroll
                    for (int n = 0; n < 2; ++n) {
                        const f32x4 v = acc[ai][bj][m][n] * (F8_SWF / 1024.0f);
                        *(unsigned*)(W + (size_t)o * 2048 + pn * 1024 + g * 256 + 128 * bj + 32 * wc + 16 * n + 4 * fq) = pk4_fp8(v[0], v[1], v[2], v[3]);
                    }
            }
    }
};

struct MoeTab { int tstart[NPAIR + 1]; int sbase[NPAIR + 1]; int cnt[NPAIR]; };
DEV void moe_build_tab(const unsigned* cntg, LAS MoeTab* tab) {
    if (threadIdx.x == 0) {
        int ts = 0, sb = 0;
        for (int q = 0; q < NPAIR; ++q) { int n = (int)cntg[q * 32]; if (n > LISTCAP) n = LISTCAP; tab->cnt[q] = n; tab->tstart[q] = ts; tab->sbase[q] = sb; const int nt = (n + 255) >> 8; ts += nt; sb += nt << 8; }
        tab->tstart[NPAIR] = ts; tab->sbase[NPAIR] = sb;
    }
    __syncthreads();
}
DEV void pair_decode(int q, int& g, int& lo, int& hi) { g = q / 6; const int r = q - 6 * g; lo = r < 3 ? 0 : (r < 5 ? 1 : 2); hi = r < 3 ? r + 1 : (r < 5 ? r - 1 : 3); }

struct JobGateUp {
    static constexpr int K = 1024, LDB = 1024, KSPLIT = 8, SWAPPED = 0, FP8 = 1, SYNC = 1;
    P p; int layer; const LAS MoeTab* tab;
    DEV const char* bbase() const { return (const char*)(p.ws + WS_WGU); }
    DEV bool get(int i, UCtx& c, const int (&Rr)[2], const int (&Cc)[2]) const {
        int ti, pn; if (!deal(i, tab->tstart[NPAIR], 8, ti, pn)) return false;
        int q = 0; while (q < NPAIR - 1 && ti >= tab->tstart[q + 1]) ++q;
        const int tin = ti - tab->tstart[q], l0 = tin << 8, np = tab->cnt[q], slot0 = tab->sbase[q] + l0;
        int g, lo, hi; pair_decode(q, g, lo, hi);
        const int e = 4 * g + (pn < 4 ? lo : hi);
        const unsigned* list = (const unsigned*)(p.ws + WS_LIST) + (size_t)q * LISTCAP;
        c.A = (const char*)(p.ws + WS_H);
        c.B0 = (const char*)(p.ws + WS_WGU) + ((size_t)(layer * 16 + e) * 1024 + 256 * (pn & 3)) * LDB; c.B1 = c.B0;
#pragma unroll
        for (int h = 0; h < 2; ++h)
#pragma unroll
            for (int k = 0; k < 2; ++k) { int pos = l0 + 128 * h + Rr[k]; if (pos >= np) pos = 0; const unsigned tok = list[pos]; c.aoff[h][k] = tok * 1024u + (unsigned)Cc[k] * 2u; }
        c.i0 = q; c.i1 = pn; c.i2 = l0; c.i3 = np; c.i4 = slot0; c.swap = 0; return true;
    }
    DEV unsigned* tile_counter(const UCtx& c) const { return (unsigned*)(p.ws + WS_CNT + 13 * KB_) + layer * 256 + tab->tstart[c.i0] + (c.i2 >> 8); }
    DEV void epi(const f32x4 (&acc)[2][2][4][2], const UCtx& c, int wr, int wc, int fr, int fq) const {
        const int q = c.i0, pn = c.i1, l0 = c.i2, np = c.i3, slot0 = c.i4;
        const float2* sw = (const float2*)(p.ws + WS_SLOTW) + (size_t)q * LISTCAP;
        unsigned char* hid = p.ws + WS_R + R_HID;
        constexpr float ISC = 1.0f / (F8_SH * F8_SW);
#pragma unroll
        for (int ai = 0; ai < 2; ++ai)
#pragma unroll
            for (int m = 0; m < 4; ++m) {
                const int r = 128 * ai + 64 * wr + 16 * m + fr; int pos = l0 + r; if (pos >= np) pos = np - 1;
                const float2 w2 = sw[pos]; const float w = (pn < 4 ? w2.x : w2.y) * (F8_SHID * ISC * ISC);
                float o[8];
#pragma unroll
                for (int n = 0; n < 2; ++n)
#pragma unroll
                    for (int k = 0; k < 4; ++k) { const float ga = acc[ai][0][m][n][k], up = acc[ai][1][m][n][k];
                        o[4 * n + k] = (w * ga) * up * __builtin_amdgcn_rcpf(1.0f + __builtin_amdgcn_exp2f(ga * (-LOG2E * ISC))); }
                u32x2 pk; pk.x = pk4_fp8(o[0], o[1], o[2], o[3]); pk.y = pk4_fp8(o[4], o[5], o[6], o[7]);
                __hip_atomic_store((unsigned long long*)(hid + (size_t)(slot0 + r) * 1024 + 128 * pn + 32 * wc + 8 * fq), ((unsigned long long)pk.y << 32) | pk.x, __ATOMIC_RELAXED, __HIP_MEMORY_SCOPE_AGENT);
            }
    }
};

template <bool OUT_F32>
struct JobDown {
    static constexpr int K = 1024, LDB = 512, KSPLIT = 4, SWAPPED = 0, FP8 = 1, SYNC = 2;
    P p; int layer; const LAS MoeTab* tab; void* outp;
    DEV const char* bbase() const { return (const char*)(p.ws + WS_WD); }
    DEV bool get(int i, UCtx& c, const int (&Rr)[2], const int (&Cc)[2]) const {
        int ti, pn; if (!deal(i, tab->tstart[NPAIR], 4, ti, pn, true)) return false;
        int q = 0; while (q < NPAIR - 1 && ti >= tab->tstart[q + 1]) ++q;
        const int tin = ti - tab->tstart[q], l0 = tin << 8, np = tab->cnt[q], slot0 = tab->sbase[q] + l0;
        int g, lo, hi; pair_decode(q, g, lo, hi);
        c.A = (const char*)(p.ws + WS_R + R_HID);
        c.B0 = (const char*)(p.ws + WS_WD) + ((size_t)(layer * 16 + 4 * g + lo) * 1024 + 256 * pn) * LDB;
        c.B1 = (const char*)(p.ws + WS_WD) + ((size_t)(layer * 16 + 4 * g + hi) * 1024 + 256 * pn) * LDB;
#pragma unroll
        for (int h = 0; h < 2; ++h)
#pragma unroll
            for (int k = 0; k < 2; ++k) c.aoff[h][k] = (unsigned)((slot0 + 128 * h + Rr[k]) * 1024 + Cc[k] * 2);
        c.i0 = q; c.i1 = pn; c.i2 = l0; c.i3 = np; c.i4 = 0; c.swap = 0; return true;
    }
    DEV unsigned* tile_counter(const UCtx& c) const { return (unsigned*)(p.ws + WS_CNT + 13 * KB_) + layer * 256 + tab->tstart[c.i0] + (c.i2 >> 8); }
    DEV void epi(const f32x4 (&acc)[2][2][4][2], const UCtx& c, int wr, int wc, int fr, int fq) const {
        const int q = c.i0, pn = c.i1, l0 = c.i2, np = c.i3;
        const unsigned* list = (const unsigned*)(p.ws + WS_LIST) + (size_t)q * LISTCAP;
        const float* gate = (const float*)(p.ws + WS_MOD) + (size_t)layer * 9 * 6144 + 5 * 1024;
        const int col0 = 256 * pn + 32 * wc + 8 * fq;
        unsigned tok[2][4];
#pragma unroll
        for (int ai = 0; ai < 2; ++ai)
#pragma unroll
            for (int m = 0; m < 4; ++m) { const int pos = l0 + 128 * ai + 64 * wr + 16 * m + fr; tok[ai][m] = list[pos < np ? pos : 0]; }
#pragma unroll
        for (int ai = 0; ai < 2; ++ai)
#pragma unroll
        for (int mp = 0; mp < 2; ++mp) {
            u32x4 bw[2][2];
#pragma unroll
            for (int mm = 0; mm < 2; ++mm) { const bf16_t* brow = (const bf16_t*)(p.ws + WS_XA) + (size_t)tok[ai][2 * mp + mm] * DM + col0;
#pragma unroll
                for (int bj = 0; bj < 2; ++bj) bw[mm][bj] = *(const u32x4*)(brow + 128 * bj); }
#pragma unroll
            for (int mm = 0; mm < 2; ++mm) {
                const int m = 2 * mp + mm;
                const int pos = l0 + 128 * ai + 64 * wr + 16 * m + fr;
                const int b = (int)(tok[ai][m] >> 12);
                const size_t ooff = (size_t)tok[ai][m] * DM + col0; const float* grow = gate + (size_t)b * 6144 + col0;
                float ssq = 0.f;
                if (pos < np) {
#pragma unroll
                    for (int bj = 0; bj < 2; ++bj) {
                        const f32x4 g0 = *(const f32x4*)(grow + 128 * bj), g1 = *(const f32x4*)(grow + 128 * bj + 4);
                        const u32x4 w = bw[mm][bj];
                        constexpr float ISC = 1.0f / (F8_SHID * F8_SW);
                        const f32x4 v0 = (f32x4){bflo(w.x), bfhi(w.x), bflo(w.y), bfhi(w.y)} + g0 * (acc[ai][bj][m][0] * ISC), v1 = (f32x4){bflo(w.z), bfhi(w.z), bflo(w.w), bfhi(w.w)} + g1 * (acc[ai][bj][m][1] * ISC);
                        if constexpr (OUT_F32) { *(f32x4*)((float*)outp + ooff + 128 * bj) = v0; *(f32x4*)((float*)outp + ooff + 128 * bj + 4) = v1; }
                        else { u32x4 o; o.x = pk_bf16(v0[0], v0[1]); o.y = pk_bf16(v0[2], v0[3]); o.z = pk_bf16(v1[0], v1[1]); o.w = pk_bf16(v1[2], v1[3]); *(u32x4*)((bf16_t*)outp + ooff + 128 * bj) = o;
                            ssq += bflo(o.x) * bflo(o.x) + bfhi(o.x) * bfhi(o.x) + bflo(o.y) * bflo(o.y) + bfhi(o.y) * bfhi(o.y) + bflo(o.z) * bflo(o.z) + bfhi(o.z) * bfhi(o.z) + bflo(o.w) * bflo(o.w) + bfhi(o.w) * bfhi(o.w); }
                    }
                }
                if constexpr (!OUT_F32) {
                    ssq += __shfl_xor(ssq, 16); ssq += __shfl_xor(ssq, 32);
                    if (pos < np && fq == 0) ((float*)(p.ws + WS_PART))[(size_t)tok[ai][m] * 16 + 4 * pn + wc] = ssq;
                }
            }
        }
    }
};

DEV int maprow(int map, int c) {
    if (map == 0) return c;
    if (map == 4) return l8row(c);
    if (map == 1) { const int t = c >> 8, wc = (c >> 6) & 3, bj = (c >> 5) & 1, fq = (c >> 3) & 3, n = (c >> 2) & 1, i = c & 3; return (t << 8) + bj * 128 + wc * 32 + n * 16 + fq * 4 + i; }
    const int t = c >> 7, wc = (c >> 5) & 3, fq = (c >> 3) & 3, n = (c >> 2) & 1, i = c & 3; return (t << 8) + (map == 3 ? 128 : 0) + wc * 32 + n * 16 + fq * 4 + i;
}
struct TT { const float* src; int ld; bf16_t* dst; int dstK; int map; int k0, c0; int f8; };
constexpr int NTT = 320 + 128 + 128 + 2048 * 3;
DEV void tt_decode(const P& p, int t, TT& o) {
    if (t < 320) { const int kb = t / 20, cb = t - 20 * kb; o.f8 = cb < 12 ? 1 : 0; o.src = p.mix_w_in; o.ld = 2560; o.dst = cb < 12 ? (bf16_t*)(p.ws + WS_WIN) : (bf16_t*)(p.ws + WS_WIN + 2 * MB_) - (size_t)1536 * 1024; o.dstK = 1024; o.map = 1; o.k0 = 64 * kb; o.c0 = 128 * cb; return; }
    t -= 320;
    if (t < 256) { const bool f = t >= 128; const int tt = t & 127, kb = tt >> 3, cb = tt & 7; o.f8 = 0; o.src = f ? p.fnet_w : p.mix_w_out; o.ld = 1024; o.dst = (bf16_t*)(p.ws + (f ? WS_WF : WS_WOUT)); o.dstK = 1024; o.map = f ? 0 : 4; o.k0 = 64 * kb; o.c0 = 128 * cb; return; }
    t -= 256;
    if (t < 4096) { const bool up = t >= 2048; const int tt = t & 2047, le = tt >> 6, r = tt & 63, kb = r >> 2, cb = r & 3;
        o.f8 = 1; o.src = (up ? p.wu : p.wg) + (size_t)le * 1024 * 512; o.ld = 512; o.dst = (bf16_t*)(p.ws + WS_WGU + (size_t)le * 1024 * 1024); o.dstK = 1024; o.map = up ? 3 : 2; o.k0 = 64 * kb; o.c0 = 128 * cb; return; }
    t -= 4096;
    { const int le = t >> 6, r = t & 63, kb = r >> 3, cb = r & 7; o.f8 = 1; o.src = p.wd + (size_t)le * 512 * 1024; o.ld = 1024; o.dst = (bf16_t*)(p.ws + WS_WD + (size_t)le * 1024 * 512); o.dstK = 512; o.map = 4; o.k0 = 64 * kb; o.c0 = 128 * cb; }
}
DEV void tt_load(const TT& t, f32x4 (&v)[4]) {
    const int tid = tid_(), rg = tid >> 5, c4 = tid & 31;
#pragma unroll
    for (int i = 0; i < 4; ++i) v[i] = *(const f32x4*)(t.src + (size_t)(t.k0 + (t.f8 ? 4 * rg + i : rg + 16 * i)) * t.ld + t.c0 + 4 * c4);
}
constexpr int TT_RS = 132;
constexpr int TT_RS8 = 80;
DEV void phase_prologue(const P& p, LAS unsigned char* lds) {
    const int tid = tid_(), G = (int)gridDim.x, bid = (int)blockIdx.x;
    unsigned char* ws = p.ws;
    for (int gt = bid * NTHREADS + tid; gt < 131072; gt += G * NTHREADS) {
        { const int row = gt >> 8, l = gt & 255, cc = row & 255; const int ph = (cc * l) & 255; const float ang = (float)ph * (6.283185307179586f / 256.0f);
          ((bf16_t*)(ws + WS_CS))[gt] = f2bf(row < 256 ? cosf(ang) : sinf(ang)); }
        { const int in = gt & 63, out = (gt >> 6) & 63, blk = (gt >> 12) & 7, gate = (gt >> 15) & 1, dir = (gt >> 16) & 1; const float* src = gate ? p.gi_w : p.gr_w;
          ((bf16_t*)(ws + WS_WGT))[gt] = f2bf(src[((dir * 8 + blk) * 64 + in) * 64 + out]); }
        if (gt < 8192) { const int row = gt >> 6, n1 = gt & 63, k1 = row & 63; const int ph = (k1 * n1) & 63; const float ang = (float)ph * (6.283185307179586f / 64.0f);
            ((bf16_t*)(ws + WS_F1))[gt] = f2bf(row < 64 ? cosf(ang) : -sinf(ang)); }
        if (gt < 16384) { const int half = gt >> 13, k2 = (gt >> 7) & 63, kk = gt & 127, n2 = kk & 63; const int ph = (k2 * n2) & 63; const float ang = (float)ph * (6.283185307179586f / 64.0f);
            const float cs = cosf(ang), sn = sinf(ang); const float v = half == 0 ? (kk < 64 ? cs : sn) : (kk < 64 ? -sn : cs);
            ((bf16_t*)(ws + WS_F2))[gt] = f2bf(v); }
        if (gt < 4096) { const int n2 = gt >> 6, k1 = gt & 63; const float ang = (float)(n2 * k1) * (6.283185307179586f / 4096.0f); ((float2*)(ws + WS_TW))[gt] = make_float2(cosf(ang), sinf(ang)); }
        if (gt < 3720) ((float*)(ws + WS_RPB2))[gt] = p.rpb[gt] * LOG2E;
        if (gt < 1024) { const float lm = p.lam[gt]; ((float*)(ws + WS_LA8))[gt] = -8.0f * log1pf(expf(-lm)); }
    }
    {
        LAS float* sc = (LAS float*)lds;
        LAS float* red = (LAS float*)(lds + 49152);
        for (int idx = tid; idx < 9 * 1024; idx += NTHREADS) { const int b = idx >> 10, k = idx & 1023; const float v = b < 8 ? p.c[b * 1024 + k] : p.c_ctx[k]; sc[k * 12 + b] = v / (1.0f + __expf(-v)); }
        __syncthreads();
        for (int task = bid; task < 768; task += G) {
            const int l = task / 384, r = task - 384 * l, chunk = r >> 2, kq = r & 3;
            const int col = tid & 63, ks = tid >> 6, n = chunk * 64 + col;
            float a[9];
#pragma unroll
            for (int b = 0; b < 9; ++b) a[b] = 0.f;
            const float* w = p.ada_w + (size_t)l * 1024 * 6144 + n; const int k0 = kq * 256 + ks * 32;
#pragma unroll 8
            for (int kk = 0; kk < 32; ++kk) { const int k = k0 + kk; const float wv = w[(size_t)k * 6144];
                const f32x4 s0 = *(const LAS f32x4*)(sc + k * 12), s1 = *(const LAS f32x4*)(sc + k * 12 + 4), s2 = *(const LAS f32x4*)(sc + k * 12 + 8);
                a[0] += wv * s0[0]; a[1] += wv * s0[1]; a[2] += wv * s0[2]; a[3] += wv * s0[3]; a[4] += wv * s1[0]; a[5] += wv * s1[1]; a[6] += wv * s1[2]; a[7] += wv * s1[3]; a[8] += wv * s2[0]; }
#pragma unroll
            for (int b = 0; b < 9; ++b) red[(ks * 64 + col) * 9 + b] = a[b];
            __syncthreads();
            if (tid < 64) {
#pragma unroll
                for (int b = 0; b < 9; ++b) { float s2 = 0.f;
#pragma unroll
                    for (int q = 0; q < 8; ++q) s2 += red[(q * 64 + tid) * 9 + b];
                    ((float*)(ws + WS_MODP))[((size_t)(kq * 2 + l) * 9 + b) * 6144 + n] = s2; }
            }
            __syncthreads();
        }
    }
    {
        LAS bf16_t* tile = (LAS bf16_t*)lds;
        int t = bid; TT cur, nx; f32x4 v[4], vn[4];
        if (t < NTT) { tt_decode(p, t, cur); tt_load(cur, v); }
        int par = 0;
        for (; t < NTT; t += G) {
            const bool hn = (t + G) < NTT;
            if (hn) { tt_decode(p, t + G, nx); tt_load(nx, vn); }
            LAS bf16_t* tl = tile + par * 64 * TT_RS;
            if (cur.f8) {
                LAS unsigned char* t8 = (LAS unsigned char*)tl;
                { const int rg = tid >> 5, c4 = tid & 31;
#pragma unroll
                  for (int j = 0; j < 4; ++j) *(LAS unsigned*)(t8 + (4 * c4 + j) * TT_RS8 + 4 * rg) = pk4_fp8(v[0][j] * F8_SW, v[1][j] * F8_SW, v[2][j] * F8_SW, v[3][j] * F8_SW); }
                __syncthreads();
                { const int cc = tid >> 2, seg = tid & 3;
                  *(u32x4*)((unsigned char*)cur.dst + (size_t)maprow(cur.map, cur.c0 + cc) * cur.dstK + cur.k0 + seg * 16) = *(const LAS u32x4*)(t8 + cc * TT_RS8 + seg * 16); }
            } else {
            { const int row = tid >> 5, c4 = tid & 31;
#pragma unroll
              for (int i = 0; i < 4; ++i) { u32x2 w; w.x = pk_bf16_asm(v[i][0], v[i][1]); w.y = pk_bf16_asm(v[i][2], v[i][3]); *(LAS u32x2*)(tl + (row + 16 * i) * TT_RS + 4 * c4) = w; } }
            __syncthreads();
#pragma unroll
            for (int j = 0; j < 2; ++j) { const int qd = tid + NTHREADS * j, cc = qd >> 3, seg = qd & 7;
                unsigned short e[8];
#pragma unroll
                for (int i = 0; i < 8; ++i) e[i] = tl[(seg * 8 + i) * TT_RS + cc];
                u32x4 w; w.x = e[0] | ((unsigned)e[1] << 16); w.y = e[2] | ((unsigned)e[3] << 16); w.z = e[4] | ((unsigned)e[5] << 16); w.w = e[6] | ((unsigned)e[7] << 16);
                *(u32x4*)(cur.dst + (size_t)maprow(cur.map, cur.c0 + cc) * cur.dstK + cur.k0 + seg * 8) = w; }
            }
            par ^= 1;
            if (hn) { cur = nx;
#pragma unroll
                for (int i = 0; i < 4; ++i) v[i] = vn[i]; }
        }
        __syncthreads();
    }
}

DEV f32x4 mod_parts4(const P& p, int l, int b, int e) {
    const float* mp = (const float*)(p.ws + WS_MODP) + ((size_t)l * 9 + b) * 6144 + e; constexpr size_t QS = (size_t)2 * 9 * 6144;
    const f32x4 a = *(const f32x4*)(mp), b1 = *(const f32x4*)(mp + QS), c = *(const f32x4*)(mp + 2 * QS), d = *(const f32x4*)(mp + 3 * QS), bs = *(const f32x4*)(p.ada_b + l * 6144 + e);
    return ((a + b1) + (c + d)) + bs;
}
DEV void phase_mod_final(const P& p) {
    const int tid = tid_();
    for (int i = (int)blockIdx.x * NTHREADS + tid; i < 2 * 9 * 6144 / 4; i += (int)gridDim.x * NTHREADS) {
        const int l = i / (9 * 1536), r = i - l * 9 * 1536, b = r / 1536, e = 4 * (r - b * 1536);
        *(f32x4*)((float*)(p.ws + WS_MOD) + ((size_t)l * 9 + b) * 6144 + e) = mod_parts4(p, l, b, e);
    }
}
template <bool PARTS, bool XBF, bool OUT8>
DEV void phase_norm_plain(const P& p, const void* xlat, int row_lo, int row_hi, int widx, int nwg, const float* gain, const float* modl  , int shift_off, int scale_off) {
    const int tid = tid_(), lane = tid & 63, wid = __builtin_amdgcn_readfirstlane(tid >> 6);
    const int gw = widx * 8 + wid, GW = nwg * 8;
    if (widx < 0) return;
    bf16_t* H = (bf16_t*)(p.ws + WS_H);
    const int nrows = row_hi - row_lo;
    const int per = (nrows + GW - 1) / GW;
    int bcur = -1; f32x4 gsc[4], sh[4];
    for (int row = row_lo + gw * per; row < row_lo + (gw + 1) * per && row < row_hi; ++row) {
        const int b = row < MTOK ? (row >> 12) : 8;
        if (b != bcur) { bcur = b; const float* mb = modl + (size_t)b * 6144;
#pragma unroll
            for (int j = 0; j < 4; ++j) { const int e = 4 * lane + 256 * j; const f32x4 g = *(const f32x4*)(gain + e); f32x4 sc;
                if constexpr (PARTS) { sc = mod_parts4(p, 0, b, scale_off + e); sh[j] = mod_parts4(p, 0, b, shift_off + e); }
                else { sc = *(const f32x4*)(mb + scale_off + e); sh[j] = *(const f32x4*)(mb + shift_off + e); }
                gsc[j] = g * (sc + 1.0f); } }
        const float* xr = row < MTOK ? (const float*)xlat + (size_t)row * DM : p.ctx + (size_t)(row - MTOK) * DM;
        f32x4 xv[4]; float ss = 0.f;
#pragma unroll
        for (int j = 0; j < 4; ++j) {
            if constexpr (XBF) { const u32x2 w = *(const u32x2*)((const bf16_t*)xlat + (size_t)row * DM + 4 * lane + 256 * j); xv[j] = (f32x4){bflo(w.x), bfhi(w.x), bflo(w.y), bfhi(w.y)}; }
            else xv[j] = *(const f32x4*)(xr + 4 * lane + 256 * j);
            ss += xv[j][0] * xv[j][0] + xv[j][1] * xv[j][1] + xv[j][2] * xv[j][2] + xv[j][3] * xv[j][3]; }
#pragma unroll
        for (int s2 = 32; s2 >= 1; s2 >>= 1) ss += __shfl_xor(ss, s2);
        const float rs = rsqrtf(ss * (1.0f / 1024.0f) + 1e-6f);
#pragma unroll
        for (int j = 0; j < 4; ++j) { const int e = 4 * lane + 256 * j;
            const f32x4 h = xv[j] * rs * gsc[j] + sh[j];
            u32x2 w; w.x = pk_bf16_asm(h[0], h[1]); w.y = pk_bf16_asm(h[2], h[3]);
            *(u32x2*)(H + (size_t)row * DM + e) = w;
            if constexpr (OUT8) *(unsigned*)((unsigned char*)p.out + (size_t)row * DM + e) = pk4_fp8(h[0] * F8_SH, h[1] * F8_SH, h[2] * F8_SH, h[3] * F8_SH); }
    }
}

DEV void phase_norm_router(const P& p, LAS unsigned char* lds, const bf16_t* xin, const float* gain, const float* modl, int layer) {
    const int tid = tid_(), lane = tid & 63, wid = __builtin_amdgcn_readfirstlane(tid >> 6);
    LAS u32x4* wh = (LAS u32x4*)lds;
    LAS u32x4* wlp = (LAS u32x4*)(lds + 32768);
    LAS float* gsl = (LAS float*)(lds + 65536 + 8192);
    LAS float* shl = (LAS float*)(lds + 65536 + 12288);
    LAS unsigned* lcnt = (LAS unsigned*)(lds + 65536);
    LAS unsigned* lbase = (LAS unsigned*)(lds + 65536 + 128);
    LAS u32x4* stash = (LAS u32x4*)(lds + 65536 + 256);
    if (tid < NPAIR) lcnt[tid] = 0u;
    bf16_t* H = (bf16_t*)(p.ws + WS_H);
    unsigned* cnt = (unsigned*)(p.ws + WS_CNT) + layer * 1024;
    unsigned* list = (unsigned*)(p.ws + WS_LIST); float2* slotw = (float2*)(p.ws + WS_SLOTW);
    const float rb = p.router_b[lane & 15];
    const int tkn = lane & 15, g = lane >> 4;
    int iter = 0;
    for (int chunk = (int)blockIdx.x; chunk < MTOK / 128; chunk += (int)gridDim.x) {
        const int b = chunk >> 5;
        const int tok0 = chunk * 128 + wid * 16;
        const bf16_t* xr = xin + (size_t)(tok0 + tkn) * DM + 8 * g;
        if (iter) __syncthreads();
        float rw[4][8], gm[2][3];
        if (iter == 0) {
#pragma unroll
            for (int i4 = 0; i4 < 4; ++i4) { const int idx = tid + NTHREADS * i4, l = idx & 63, ks = idx >> 6, e = l & 15, g2 = l >> 4;
#pragma unroll
                for (int q = 0; q < 8; ++q) rw[i4][q] = p.router_w[(32 * ks + 8 * g2 + q) * 16 + e]; }
        }
        { const float* mb = modl + (size_t)b * 6144;
#pragma unroll
          for (int kk = 0; kk < 2; ++kk) { const int k = tid + NTHREADS * kk; gm[kk][0] = gain[k]; gm[kk][1] = mb[4096 + k]; gm[kk][2] = mb[3072 + k]; } }
        u32x4 wv[32];
#pragma unroll
        for (int ks = 0; ks < 32; ++ks) wv[ks] = *(const u32x4*)(xr + 32 * ks);
        if (iter == 0) {
#pragma unroll
            for (int i4 = 0; i4 < 4; ++i4) { const int idx = tid + NTHREADS * i4; unsigned hi[4], lo[4];
#pragma unroll
                for (int q = 0; q < 4; ++q) { const float w0 = rw[i4][2 * q], w1 = rw[i4][2 * q + 1]; hi[q] = pk_bf16_asm(w0, w1); lo[q] = pk_bf16_asm(w0 - bflo(hi[q]), w1 - bfhi(hi[q])); }
                wh[idx] = (u32x4){hi[0], hi[1], hi[2], hi[3]}; wlp[idx] = (u32x4){lo[0], lo[1], lo[2], lo[3]}; }
        }
#pragma unroll
        for (int kk = 0; kk < 2; ++kk) { const int k = tid + NTHREADS * kk; gsl[k] = gm[kk][0] * (gm[kk][1] + 1.0f); shl[k] = gm[kk][2]; }
        __syncthreads();
        float ss = 0.f;
#pragma unroll
        for (int ks = 0; ks < 32; ++ks) { const u32x4 w = wv[ks]; const float a0 = bflo(w.x), a1 = bfhi(w.x), a2 = bflo(w.y), a3 = bfhi(w.y), a4 = bflo(w.z), a5 = bfhi(w.z), a6 = bflo(w.w), a7 = bfhi(w.w);
            ss += (a0 * a0 + a1 * a1) + (a2 * a2 + a3 * a3) + (a4 * a4 + a5 * a5) + (a6 * a6 + a7 * a7); }
        ss += __shfl_xor(ss, 16); ss += __shfl_xor(ss, 32);
        const float rs = rsqrtf(ss * (1.0f / 1024.0f) + 1e-6f);
        f32x4 lg = (f32x4){0.f, 0.f, 0.f, 0.f};
        unsigned char* hrow = (unsigned char*)H + (size_t)(tok0 + tkn) * DM + 8 * g;
#pragma unroll 8
        for (int ks = 0; ks < 32; ++ks) {
            const u32x4 w = *(const u32x4*)(xr + 32 * ks);
            const f32x4 g0 = *(const LAS f32x4*)(gsl + 32 * ks + 8 * g), g1 = *(const LAS f32x4*)(gsl + 32 * ks + 8 * g + 4), s0 = *(const LAS f32x4*)(shl + 32 * ks + 8 * g), s1 = *(const LAS f32x4*)(shl + 32 * ks + 8 * g + 4);
            const float h0 = bflo(w.x) * rs * g0[0] + s0[0], h1 = bfhi(w.x) * rs * g0[1] + s0[1], h2 = bflo(w.y) * rs * g0[2] + s0[2], h3 = bfhi(w.y) * rs * g0[3] + s0[3];
            const float h4 = bflo(w.z) * rs * g1[0] + s1[0], h5 = bfhi(w.z) * rs * g1[1] + s1[1], h6 = bflo(w.w) * rs * g1[2] + s1[2], h7 = bfhi(w.w) * rs * g1[3] + s1[3];
            u32x4 hh; hh.x = pk_bf16(h0, h1); hh.y = pk_bf16(h2, h3); hh.z = pk_bf16(h4, h5); hh.w = pk_bf16(h6, h7);
            { u32x2 h8; h8.x = pk4_fp8(h0 * F8_SH, h1 * F8_SH, h2 * F8_SH, h3 * F8_SH); h8.y = pk4_fp8(h4 * F8_SH, h5 * F8_SH, h6 * F8_SH, h7 * F8_SH); *(u32x2*)(hrow + 32 * ks) = h8; }
            u32x4 hl; hl.x = pk_bf16(h0 - bflo(hh.x), h1 - bfhi(hh.x)); hl.y = pk_bf16(h2 - bflo(hh.y), h3 - bfhi(hh.y)); hl.z = pk_bf16(h4 - bflo(hh.z), h5 - bfhi(hh.z)); hl.w = pk_bf16(h6 - bflo(hh.w), h7 - bfhi(hh.w));
            const bf16x8 ahi = __builtin_bit_cast(bf16x8, hh), alo = __builtin_bit_cast(bf16x8, hl);
            const bf16x8 bhi = __builtin_bit_cast(bf16x8, wh[ks * 64 + lane]), blo = __builtin_bit_cast(bf16x8, wlp[ks * 64 + lane]);
            lg = __builtin_amdgcn_mfma_f32_16x16x32_bf16(ahi, bhi, lg, 0, 0, 0);
            lg = __builtin_amdgcn_mfma_f32_16x16x32_bf16(ahi, blo, lg, 0, 0, 0);
            lg = __builtin_amdgcn_mfma_f32_16x16x32_bf16(alo, bhi, lg, 0, 0, 0);
        }
#pragma unroll
        for (int v = 0; v < 4; ++v) {
        const float logit = lg[v];
        const float score = 1.0f / (1.0f + expf(-logit)); const float sel = score + rb;
        const int qb = lane & ~3, tb = lane & ~15;
        const float s0 = __shfl(sel, qb), s1 = __shfl(sel, qb + 1), s2 = __shfl(sel, qb + 2), s3 = __shfl(sel, qb + 3);
        const float ma = fmaxf(s0, s1), mi = fminf(s0, s1), mc = fmaxf(s2, s3), md = fminf(s2, s3);
        const float gsum = fmaxf(ma, mc) + fmaxf(fminf(ma, mc), fmaxf(mi, md));
        const float g0 = __shfl(gsum, tb), g1 = __shfl(gsum, tb + 4), g2 = __shfl(gsum, tb + 8), g3 = __shfl(gsum, tb + 12);
        int best = 0; float bv = g0; if (g1 > bv) { bv = g1; best = 1; } if (g2 > bv) { bv = g2; best = 2; } if (g3 > bv) { bv = g3; best = 3; }
        const int eb = tb + 4 * best;
        float tv[4], cv[4];
#pragma unroll
        for (int q = 0; q < 4; ++q) { tv[q] = __shfl(sel, eb + q); cv[q] = __shfl(score, eb + q); }
        int ia = 0; float va = tv[0];
#pragma unroll
        for (int q = 1; q < 4; ++q) if (tv[q] > va) { va = tv[q]; ia = q; }
        int ib = -1; float vb = -3.0e38f;
#pragma unroll
        for (int q = 0; q < 4; ++q) if (q != ia && tv[q] > vb) { vb = tv[q]; ib = q; }
        float sa = 0.f, sb = 0.f;
#pragma unroll
        for (int q = 0; q < 4; ++q) { sa = (q == ia) ? cv[q] : sa; sb = (q == ib) ? cv[q] : sb; }
        const float inv = 1.0f / (sa + sb); const float wa = sa * inv, wb = sb * inv;
        const int lo = ia < ib ? ia : ib, hi = ia < ib ? ib : ia; const float wlo = ia < ib ? wa : wb, whi = ia < ib ? wb : wa;
        const int pidx = lo == 0 ? hi - 1 : (lo == 1 ? hi + 1 : 5);
        const int pair = best * 6 + pidx; const float wlo_ = wlo, whi_ = whi;
        if ((lane & 15) == 0) {
            const unsigned lpos = __hip_atomic_fetch_add(&lcnt[pair], 1u, __ATOMIC_RELAXED, __HIP_MEMORY_SCOPE_WORKGROUP);
            stash[(wid * 8 + iter * 4 + v) * 4 + (lane >> 4)] = (u32x4){(unsigned)pair, lpos, __float_as_uint(wlo_), __float_as_uint(whi_)};
        }
        }
        ++iter;
    }
    __syncthreads();
    if (tid < NPAIR) lbase[tid] = atomicAdd(&cnt[tid * 32], lcnt[tid]);
    __syncthreads();
    if (lane < 4) {
        int it2 = 0;
        for (int chunk = (int)blockIdx.x; chunk < MTOK / 128; chunk += (int)gridDim.x, ++it2) {
#pragma unroll
            for (int v = 0; v < 4; ++v) {
                const u32x4 sv = stash[(wid * 8 + it2 * 4 + v) * 4 + lane];
                const unsigned pair = sv.x, pos = lbase[pair] + sv.y;
                if (pos < (unsigned)LISTCAP) { list[(size_t)pair * LISTCAP + pos] = (unsigned)(chunk * 128 + wid * 16 + 4 * lane + v); slotw[(size_t)pair * LISTCAP + pos] = make_float2(__uint_as_float(sv.z), __uint_as_float(sv.w)); }
            }
        }
    }
    __syncthreads();
}

constexpr int AT_KC = 0, AT_KROW = 144;
constexpr int AT_VC = 256 * AT_KROW, AT_VROW = 528;
constexpr int AT_TB = AT_VC + 64 * AT_VROW;
constexpr int AT_IX = AT_TB + 2048;
DEV void phase_attention(const P& p, LAS unsigned char* lds) {
    const int tid = tid_(), lane = tid & 63, wid = __builtin_amdgcn_readfirstlane(tid >> 6);
    const unsigned char* R = p.ws + WS_R;
    const bf16_t* Q = (const bf16_t*)(R + R_Q); const bf16_t* Kb = (const bf16_t*)(R + R_K); const bf16_t* VT = (const bf16_t*)(R + R_VT);
    const bf16_t* KC = (const bf16_t*)(R + R_KC); const bf16_t* VCT = (const bf16_t*)(R + R_VCT);
    bf16_t* MIX = (bf16_t*)(p.ws + WS_R + R_MIX);
    const float* rpb2 = (const float*)(p.ws + WS_RPB2);
    if (tid < 64) {
#pragma unroll
        for (int cm = 0; cm < 6; ++cm) {
            const int c = cm / 3, cb = cm - 3 * c + c, qc = 16 * cb + (lane & 15), cs = clampi(qc - 8, 0, 48);
            unsigned w0 = 0u, w1 = 0u;
#pragma unroll
            for (int t = 0; t < 8; ++t) { const int kc = 32 * c + 8 * (lane >> 4) + t; const bool valid = kc >= cs && kc < cs + 16; const unsigned id = valid ? (unsigned)(clampi(kc - qc, -15, 15) + 15) : 31u;
                if (t < 4) w0 |= (id * 4u) << (8 * t); else w1 |= (id * 4u) << (8 * (t - 4)); }
            *(LAS u32x2*)(lds + AT_IX + (cm * 64 + lane) * 8) = (u32x2){w0, w1};
        }
    }
    const int nun = NB * 8 * 8, uper = (nun + (int)gridDim.x - 1) / (int)gridDim.x;
    int staged = -1;
    for (int u = (int)blockIdx.x * uper; u < ((int)blockIdx.x + 1) * uper && u < nun; ++u) {
        const int band = u & 7, h = (u >> 3) & 7, b = u >> 6;
        __syncthreads();
        int tl = tid; asm volatile("" : "+v"(tl));
        if ((u >> 3) != staged) { staged = u >> 3;
#pragma unroll
        for (int i = 0; i < 4; ++i) { const int cid = tl + NTHREADS * i;
            { const int key = cid >> 3, part = cid & 7; *(LAS u32x4*)(lds + AT_KC + key * AT_KROW + part * 16) = *(const u32x4*)(KC + (size_t)(b * CTXL + key) * 512 + h * 64 + part * 8); }
            { const int d = cid >> 5, part = cid & 31; *(LAS u32x4*)(lds + AT_VC + d * AT_VROW + part * 16) = *(const u32x4*)(VCT + (size_t)((b * 8 + h) * 64 + d) * CTXL + part * 8); } }
        if (tl < 480) { const int dr = tl >> 5, q = tl & 31; ((LAS float*)(lds + AT_TB))[tl] = q < 31 ? rpb2[h * 465 + dr * 31 + q] : -1.0e30f; }
        }
        __syncthreads();
        int ln = lane; asm volatile("" : "+v"(ln));
        const int j = ln & 15, g = ln >> 4, kap0 = 8 * (j >> 2) + (j & 3);
        const int r = 8 * band + wid;
        const int rs = clampi(r - 4, 0, 56);
        bf16x8 qf[4][2];
#pragma unroll
        for (int cb = 0; cb < 4; ++cb)
#pragma unroll
            for (int ks = 0; ks < 2; ++ks) qf[cb][ks] = *(const bf16x8*)(Q + (size_t)(b * SEQ + r * 64 + 16 * cb + j) * 512 + h * 64 + 32 * ks + 8 * g);
        f32x4 O[4][4]; float l[4];
#pragma unroll
        for (int cb = 0; cb < 4; ++cb) { l[cb] = 0.f;
#pragma unroll
            for (int db = 0; db < 4; ++db) O[cb][db] = (f32x4){0.f, 0.f, 0.f, 0.f}; }
        const bf16_t* vtb = VT + (size_t)((b * 8 + h) * 64 + j) * SEQ;
#define AT_LOADW(KF, VF, krow_, c_) do { const int ktok0_ = b * SEQ + (krow_) * 64 + 32 * (c_); \
            _Pragma("unroll") for (int blk = 0; blk < 2; ++blk) _Pragma("unroll") for (int ks = 0; ks < 2; ++ks) KF[blk][ks] = *(const bf16x8*)(Kb + (size_t)(ktok0_ + kap0 + 4 * blk) * 512 + h * 64 + 32 * ks + 8 * g); \
            _Pragma("unroll") for (int db = 0; db < 4; ++db) VF[db] = *(const bf16x8*)(vtb + (size_t)(16 * db) * SEQ + (krow_) * 64 + 32 * (c_) + 8 * g); } while (0)
#define AT_EVALW(KF, VF, c_) do { _Pragma("unroll") for (int q3 = 0; q3 < 3; ++q3) { const int cb = q3 + (c_), cm = 3 * (c_) + q3; f32x4 s_[2]; \
            _Pragma("unroll") for (int blk = 0; blk < 2; ++blk) { s_[blk] = __builtin_amdgcn_mfma_f32_16x16x32_bf16(KF[blk][0], qf[cb][0], (f32x4){0.f, 0.f, 0.f, 0.f}, 0, 0, 0); \
                s_[blk] = __builtin_amdgcn_mfma_f32_16x16x32_bf16(KF[blk][1], qf[cb][1], s_[blk], 0, 0, 0); } \
            float pv[8]; const u32x2 iw2 = *(const LAS u32x2*)(lds + AT_IX + (cm * 64 + ln) * 8); const unsigned iw[2] = {iw2.x, iw2.y}; \
            _Pragma("unroll") for (int t = 0; t < 8; ++t) { const unsigned off = (iw[t >> 2] >> (8 * (t & 3))) & 0xffu; const float bias = *(const LAS float*)(lds + tbrow + off); \
                pv[t] = __builtin_amdgcn_exp2f(s_[t >> 2][t & 3] + bias); l[cb] += pv[t]; } \
            u32x4 pw; pw.x = pk_bf16(pv[0], pv[1]); pw.y = pk_bf16(pv[2], pv[3]); pw.z = pk_bf16(pv[4], pv[5]); pw.w = pk_bf16(pv[6], pv[7]); \
            const bf16x8 pf = __builtin_bit_cast(bf16x8, pw); \
            _Pragma("unroll") for (int db = 0; db < 4; ++db) O[cb][db] = __builtin_amdgcn_mfma_f32_16x16x32_bf16(VF[db], pf, O[cb][db], 0, 0, 0); \
            if (q3 == 2) __builtin_amdgcn_sched_barrier(0); } } while (0)
#define AT_LOADC(KF, VF, c_) do { _Pragma("unroll") for (int blk = 0; blk < 2; ++blk) _Pragma("unroll") for (int ks = 0; ks < 2; ++ks) \
                KF[blk][ks] = *(const LAS bf16x8*)(lds + AT_KC + (32 * (c_) + kap0 + 4 * blk) * AT_KROW + ks * 64 + g * 16); \
            _Pragma("unroll") for (int db = 0; db < 4; ++db) VF[db] = *(const LAS bf16x8*)(lds + AT_VC + (16 * db + j) * AT_VROW + (c_) * 64 + g * 16); } while (0)
#define AT_EVALC(KF, VF, CB0) do { _Pragma("unroll") for (int cb = (CB0); cb < (CB0) + 2; ++cb) { f32x4 s_[2]; \
            _Pragma("unroll") for (int blk = 0; blk < 2; ++blk) { s_[blk] = __builtin_amdgcn_mfma_f32_16x16x32_bf16(KF[blk][0], qf[cb][0], (f32x4){0.f, 0.f, 0.f, 0.f}, 0, 0, 0); \
                s_[blk] = __builtin_amdgcn_mfma_f32_16x16x32_bf16(KF[blk][1], qf[cb][1], s_[blk], 0, 0, 0); } \
            float pv[8]; _Pragma("unroll") for (int t = 0; t < 8; ++t) { pv[t] = __builtin_amdgcn_exp2f(s_[t >> 2][t & 3]); l[cb] += pv[t]; } \
            u32x4 pw; pw.x = pk_bf16(pv[0], pv[1]); pw.y = pk_bf16(pv[2], pv[3]); pw.z = pk_bf16(pv[4], pv[5]); pw.w = pk_bf16(pv[6], pv[7]); \
            const bf16x8 pf = __builtin_bit_cast(bf16x8, pw); \
            _Pragma("unroll") for (int db = 0; db < 4; ++db) O[cb][db] = __builtin_amdgcn_mfma_f32_16x16x32_bf16(VF[db], pf, O[cb][db], 0, 0, 0); \
            if (cb & 1) __builtin_amdgcn_sched_barrier(0); } } while (0)
        {
            bf16x8 kfa[2][2], vfa[4], kfb[2][2], vfb[4];
            AT_LOADW(kfa, vfa, rs, 0);
            for (int i = 0; i < 8; ++i) {
                const int krow = rs + i;
                const unsigned tbrow = (unsigned)(AT_TB + (krow - r + 7) * 128);
                AT_LOADW(kfb, vfb, krow, 1);
                __builtin_amdgcn_sched_barrier(0);
                AT_EVALW(kfa, vfa, 0);
                AT_LOADC(kfa, vfa, i);
                AT_EVALC(kfa, vfa, 0);
                { const int kn = i < 7 ? krow + 1 : krow; AT_LOADW(kfa, vfa, kn, 0); }
                __builtin_amdgcn_sched_barrier(0);
                AT_EVALW(kfb, vfb, 1);
                AT_LOADC(kfb, vfb, i);
                AT_EVALC(kfb, vfb, 2);
            }
        }
#undef AT_LOADW
#undef AT_EVALW
#undef AT_LOADC
#undef AT_EVALC
#pragma unroll
        for (int cb = 0; cb < 4; ++cb) {
            float lt = l[cb]; lt += __shfl_xor(lt, 16); lt += __shfl_xor(lt, 32);
            const float inv = 1.0f / lt;
            const size_t qtok = (size_t)b * SEQ + r * 64 + 16 * cb + j;
#pragma unroll
            for (int db = 0; db < 4; ++db) { const f32x4 o = O[cb][db] * inv; u32x2 w; w.x = pk_bf16(o[0], o[1]); w.y = pk_bf16(o[2], o[3]);
                *(u32x2*)(MIX + qtok * DM + h * 64 + 16 * db + 4 * g) = w; }
        }
    }
    __syncthreads();
}

DEV float fast_sigmoid(float z) { return __builtin_amdgcn_rcpf(1.0f + __builtin_amdgcn_exp2f(-LOG2E * z)); }
struct LruGates { f32x16 acc[4]; f32x16 xc; bool poly; };
DEV void lru_xload(const bf16_t* xb, int T, int p0, int cg, int lane, u32x4 (&xw)[4][4], int& okm) {
    const int blk = cg >> 1, i = lane & 31, hh = lane >> 5;
    const int pos = p0 + 16 * ((i >> 2) & 1) + 4 * (i >> 3) + (i & 3);
    okm = 0;
#pragma unroll
    for (int tap = 0; tap < 4; ++tap) { const int pp = pos + tap - 2, pr = clampi(pp, 0, T - 1); okm |= (pp == pr) ? (1 << tap) : 0;
#pragma unroll
        for (int ks = 0; ks < 4; ++ks) xw[ks][tap] = *(const u32x4*)(xb + (size_t)pr * 512 + 64 * blk + 16 * ks + 8 * hh); }
}
DEV void lru_gates(const P& p, const LAS float* cw, int cg, int lane, const u32x4 (&xw)[4][4], int okm, const float (&la8)[2], LruGates& G) {
    const int blk = cg >> 1, half = cg & 1, i = lane & 31, hh = lane >> 5;
    const bf16_t* wgt = (const bf16_t*)(p.ws + WS_WGT) + (size_t)(blk * 64 + 32 * half + i) * 64 + 8 * hh;
#pragma unroll
    for (int gd = 0; gd < 4; ++gd)
#pragma unroll
        for (int q = 0; q < 16; ++q) G.acc[gd][q] = 0.f;
#pragma unroll
    for (int q = 0; q < 16; ++q) G.xc[q] = 0.f;
#pragma unroll
    for (int ks = 0; ks < 4; ++ks) {
        bf16x8 bw[4];
#pragma unroll
        for (int gd = 0; gd < 4; ++gd) bw[gd] = *(const bf16x8*)(wgt + gd * (8 * 64 * 64) + 16 * ks);
        const int ch0 = 64 * blk + 16 * ks + 8 * hh;
        float xc[8];
        { const f32x4 b0 = *(const LAS f32x4*)(cw + 2048 + ch0), b1 = *(const LAS f32x4*)(cw + 2048 + ch0 + 4);
          xc[0] = b0[0]; xc[1] = b0[1]; xc[2] = b0[2]; xc[3] = b0[3]; xc[4] = b1[0]; xc[5] = b1[1]; xc[6] = b1[2]; xc[7] = b1[3]; }
#pragma unroll
        for (int tap = 0; tap < 4; ++tap) {
            const f32x4 w0 = *(const LAS f32x4*)(cw + tap * 512 + ch0), w1 = *(const LAS f32x4*)(cw + tap * 512 + ch0 + 4);
            u32x4 x = xw[ks][tap]; if (!((okm >> tap) & 1)) x = (u32x4){0u, 0u, 0u, 0u};
            xc[0] += w0[0] * bflo(x.x); xc[1] += w0[1] * bfhi(x.x); xc[2] += w0[2] * bflo(x.y); xc[3] += w0[3] * bfhi(x.y);
            xc[4] += w1[0] * bflo(x.z); xc[5] += w1[1] * bfhi(x.z); xc[6] += w1[2] * bflo(x.w); xc[7] += w1[3] * bfhi(x.w);
        }
        u32x4 aw; aw.x = pk_bf16(xc[0], xc[1]); aw.y = pk_bf16(xc[2], xc[3]); aw.z = pk_bf16(xc[4], xc[5]); aw.w = pk_bf16(xc[6], xc[7]);
        const bf16x8 af = __builtin_bit_cast(bf16x8, aw);
#pragma unroll
        for (int gd = 0; gd < 4; ++gd) G.acc[gd] = __builtin_amdgcn_mfma_f32_32x32x16_bf16(af, bw[gd], G.acc[gd], 0, 0, 0);
        if ((ks >> 1) == half) {
            const int tt = i - 16 * (ks & 1) - 8 * hh;
            u32x4 idw = (u32x4){0u, 0u, 0u, 0u};
            const unsigned one = (tt >= 0 && tt < 8) ? (0x3F80u << (16 * (tt & 1))) : 0u;
            idw.x = (tt >> 1) == 0 ? one : 0u; idw.y = (tt >> 1) == 1 ? one : 0u; idw.z = (tt >> 1) == 2 ? one : 0u; idw.w = (tt >> 1) == 3 ? one : 0u;
            G.xc = __builtin_amdgcn_mfma_f32_32x32x16_bf16(af, __builtin_bit_cast(bf16x8, idw), G.xc, 0, 0, 0);
        }
        __builtin_amdgcn_sched_barrier(0);
    }
    asm volatile("s_nop 15\n\ts_nop 15" ::: "memory");
    __builtin_amdgcn_sched_barrier(0);
    G.poly = !__any((la8[0] < -0.25f) || (la8[1] < -0.25f));
}
DEV void lru_elem(const LruGates& G, int r, int d, const float (&la8)[2], const float (&br)[2], const float (&bi)[2], float& a, float& bt) {
    const float rg = fast_sigmoid(G.acc[2 * d][r] + br[d]), ig = fast_sigmoid(G.acc[2 * d + 1][r] + bi[d]);
    const float x = rg * la8[d]; float m;
    if (G.poly) { const float e1 = x * (1.0f + x * (0.5f + x * (0.16666667f + x * (0.041666668f + x * 0.0083333338f)))); a = 1.0f + e1; m = -e1 * (2.0f + e1); }
    else { a = __builtin_amdgcn_exp2f(LOG2E * x); m = 1.0f - __builtin_amdgcn_exp2f(2.0f * LOG2E * x); }
    bt = __builtin_amdgcn_sqrtf(m) * ig * G.xc[r];
}
DEV void lru_load_w(const P& p, int cg, int lane, float (&la8)[2], float (&br)[2], float (&bi)[2]) {
    const int c = 64 * (cg >> 1) + 32 * (cg & 1) + (lane & 31);
#pragma unroll
    for (int d = 0; d < 2; ++d) { la8[d] = ((const float*)(p.ws + WS_LA8))[d * 512 + c]; br[d] = p.gr_b[d * 512 + c]; bi[d] = p.gi_b[d * 512 + c]; }
}
DEV void phase_lru1(const P& p, LAS unsigned char* lds) {
    const int tid = tid_(), lane = tid & 63, wid = __builtin_amdgcn_readfirstlane(tid >> 6);
    const int gw = (int)blockIdx.x * 8 + wid, GW = (int)gridDim.x * 8;
    const int cg = gw & 15, hh = lane >> 5;
    LAS float* cw = (LAS float*)lds;
    for (int q = tid; q < 2560; q += NTHREADS) cw[q] = q < 2048 ? p.conv_w[q] : p.conv_b[q - 2048];
    __syncthreads();
    float la8[2], br[2], bi[2];
    lru_load_w(p, cg, lane, la8, br, bi);
    const bf16_t* XB = (const bf16_t*)(p.ws + WS_R + R_XB); const bf16_t* XBC = (const bf16_t*)(p.ws + WS_R + R_XBC);
    float2* SUM = (float2*)(p.ws + WS_SUM);
    unsigned* AB = (unsigned*)p.out;
    const int c = 64 * (cg >> 1) + 32 * (cg & 1) + (lane & 31);
    const int it0 = gw >> 4, itS = GW >> 4;
    u32x4 xw[4][4]; int okm = 0;
    if (it0 < NB * 136) { const int b = it0 / 136, tile = it0 - 136 * b; const bool isc = tile < 8;
        lru_xload(isc ? XBC + (size_t)b * CTXL * 512 : XB + (size_t)b * SEQ * 512, isc ? CTXL : SEQ, isc ? 32 * tile : 32 * (tile - 8), cg, lane, xw, okm); }
    for (int it = it0; it < NB * 136; it += itS) {
        const int b = it / 136, tile = it - 136 * b;
        const bool isc = tile < 8;
        int ln = lane; asm volatile("" : "+v"(ln));
        LruGates G; lru_gates(p, cw, cg, ln, xw, okm, la8, G);
        { const int itn = it + itS;
          if (itn < NB * 136) { const int bn = itn / 136, tn = itn - 136 * bn; const bool iscn = tn < 8;
              lru_xload(iscn ? XBC + (size_t)bn * CTXL * 512 : XB + (size_t)bn * SEQ * 512, iscn ? CTXL : SEQ, iscn ? 32 * tn : 32 * (tn - 8), cg, lane, xw, okm); } }
        unsigned* ab = AB + ((size_t)((b * 128 + (tile - 8)) * 16 + cg) * 32) * 64 + ln;
        float Af = 1.f, Hf = 0.f, Ab = 1.f, Hb = 0.f;
#pragma unroll
        for (int rp = 0; rp < 8; ++rp) {
            float a0, t0, a1, t1; lru_elem(G, 2 * rp, 0, la8, br, bi, a0, t0); lru_elem(G, 2 * rp + 1, 0, la8, br, bi, a1, t1);
            const unsigned ua = pk_bf16(1.0f - a0, 1.0f - a1), ut = pk_bf16(t0, t1);
            if (!isc) { ab[(0 * 8 + rp) * 64] = ua; ab[(1 * 8 + rp) * 64] = ut; }
            a0 = 1.0f - bflo(ua); a1 = 1.0f - bfhi(ua); t0 = bflo(ut); t1 = bfhi(ut);
            Hf = a0 * Hf + t0; Af *= a0; Hf = a1 * Hf + t1; Af *= a1;
            __builtin_amdgcn_sched_barrier(0);
        }
#pragma unroll
        for (int rp = 7; rp >= 0; --rp) {
            float a0, t0, a1, t1; lru_elem(G, 2 * rp, 1, la8, br, bi, a0, t0); lru_elem(G, 2 * rp + 1, 1, la8, br, bi, a1, t1);
            const unsigned ua = pk_bf16(1.0f - a0, 1.0f - a1), ut = pk_bf16(t0, t1);
            if (!isc) { ab[(2 * 8 + rp) * 64] = ua; ab[(3 * 8 + rp) * 64] = ut; }
            a0 = 1.0f - bflo(ua); a1 = 1.0f - bfhi(ua); t0 = bflo(ut); t1 = bfhi(ut);
            Hb = a1 * Hb + t1; Ab *= a1; Hb = a0 * Hb + t0; Ab *= a0;
            __builtin_amdgcn_sched_barrier(0);
        }
        const float oAf = __shfl_xor(Af, 32), oHf = __shfl_xor(Hf, 32), oAb = __shfl_xor(Ab, 32), oHb = __shfl_xor(Hb, 32);
        const float Af_lo = hh ? oAf : Af, Hf_lo = hh ? oHf : Hf, Af_up = hh ? Af : oAf, Hf_up = hh ? Hf : oHf;
        const float Ab_lo = hh ? oAb : Ab, Hb_lo = hh ? oHb : Hb, Ab_up = hh ? Ab : oAb, Hb_up = hh ? Hb : oHb;
        const float2 fw = make_float2(Af_lo * Af_up, Af_up * Hf_lo + Hf_up);
        const float2 bw = make_float2(Ab_lo * Ab_up, Ab_lo * Hb_up + Hb_lo);
        SUM[((size_t)(b * 136 + tile) * 2 + (ln >> 5)) * 512 + 64 * (cg >> 1) + 32 * (cg & 1) + (ln & 31)] = (ln >> 5) ? bw : fw;
    }
}
DEV void phase_lru_carry(const P& p) {
    const int tid = tid_(), lane = tid & 63;
    const int gwv = (int)blockIdx.x * 8 + __builtin_amdgcn_readfirstlane(tid >> 6);
    if (gwv >= NB * 2 * 64) return;
    const int seg = lane >> 3, c = (gwv & 63) * 8 + (lane & 7), dir = (gwv >> 6) & 1, b = gwv >> 7;
    const float2* SUM = (const float2*)(p.ws + WS_SUM); float* CAR = (float*)(p.ws + WS_CAR);
    float2 sv[17]; int tl[17];
#pragma unroll
    for (int q = 0; q < 17; ++q) { const int o = 17 * seg + q; tl[q] = dir == 0 ? o : (o < 8 ? 7 - o : 143 - o); sv[q] = SUM[((size_t)(b * 136 + tl[q]) * 2 + dir) * 512 + c]; }
    float A = 1.f, H = 0.f;
#pragma unroll
    for (int q = 0; q < 17; ++q) { H = sv[q].x * H + sv[q].y; A *= sv[q].x; }
    float h = 0.f, mine = 0.f;
#pragma unroll
    for (int sg = 0; sg < 8; ++sg) { const float As = __shfl(A, sg * 8 + (lane & 7)), Hs = __shfl(H, sg * 8 + (lane & 7)); if (sg == seg) mine = h; h = As * h + Hs; }
    h = mine;
#pragma unroll
    for (int q = 0; q < 17; ++q) { if (tl[q] >= 8) CAR[((size_t)(b * 128 + tl[q] - 8) * 2 + dir) * 512 + c] = h; h = sv[q].x * h + sv[q].y; }
}
DEV void phase_lru2(const P& p) {
    const int tid = tid_(), lane = tid & 63, wid = __builtin_amdgcn_readfirstlane(tid >> 6);
    const int gw = (int)blockIdx.x * 8 + wid, GW = (int)gridDim.x * 8;
    const int cg = gw & 15, hh = lane >> 5;
    const bf16_t* GB = (const bf16_t*)(p.ws + WS_R + R_GB);
    bf16_t* MIX = (bf16_t*)(p.ws + WS_R + R_MIX);
    const float* CAR = (const float*)(p.ws + WS_CAR);
    const unsigned* AB = (const unsigned*)p.out;
    const int c = 64 * (cg >> 1) + 32 * (cg & 1) + (lane & 31);
    for (int it = gw >> 4; it < NB * 128; it += GW >> 4) {
        const int b = it >> 7, tile = it & 127, p0 = 32 * tile;
        const unsigned* ab = AB + ((size_t)((b * 128 + tile) * 16 + cg) * 32) * 64 + lane;
        unsigned u[4][8];
#pragma unroll
        for (int k = 0; k < 4; ++k)
#pragma unroll
            for (int rp = 0; rp < 8; ++rp) u[k][rp] = ab[(k * 8 + rp) * 64];
        const float cf = CAR[((size_t)(b * 128 + tile) * 2 + 0) * 512 + c], cbk = CAR[((size_t)(b * 128 + tile) * 2 + 1) * 512 + c];
        unsigned short gbv[16];
#pragma unroll
        for (int r = 0; r < 16; ++r) gbv[r] = GB[((size_t)b * SEQ + p0 + 16 * hh + r) * 512 + c];
        float y[16], Pf[16], Pb[16];
        float Af = 1.f, Hf = 0.f, Ab = 1.f, Hb = 0.f;
#pragma unroll
        for (int rp = 0; rp < 8; ++rp) {
            const float a0 = 1.0f - bflo(u[0][rp]), a1 = 1.0f - bfhi(u[0][rp]), t0 = bflo(u[1][rp]), t1 = bfhi(u[1][rp]);
            Hf = a0 * Hf + t0; Af *= a0; y[2 * rp] = Hf; Pf[2 * rp] = Af;
            Hf = a1 * Hf + t1; Af *= a1; y[2 * rp + 1] = Hf; Pf[2 * rp + 1] = Af;
        }
#pragma unroll
        for (int rp = 7; rp >= 0; --rp) {
            const float a0 = 1.0f - bflo(u[2][rp]), a1 = 1.0f - bfhi(u[2][rp]), t0 = bflo(u[3][rp]), t1 = bfhi(u[3][rp]);
            Hb = a1 * Hb + t1; Ab *= a1; y[2 * rp + 1] += Hb; Pb[2 * rp + 1] = Ab;
            Hb = a0 * Hb + t0; Ab *= a0; y[2 * rp] += Hb; Pb[2 * rp] = Ab;
        }
        const float oAf = __shfl_xor(Af, 32), oHf = __shfl_xor(Hf, 32), oAb = __shfl_xor(Ab, 32), oHb = __shfl_xor(Hb, 32);
        const float sf = hh ? (oAf * cf + oHf) : cf;
        const float sb = hh ? cbk : (oAb * cbk + oHb);
#pragma unroll
        for (int r = 0; r < 16; ++r) { const size_t tok = (size_t)b * SEQ + p0 + 16 * hh + r;
            MIX[tok * DM + 512 + c] = f2bf(bf2f(gbv[r]) * (y[r] + Pf[r] * sf + Pb[r] * sb)); }
    }
}

DEV unsigned perm_lo(unsigned w1, unsigned w0) { return __builtin_amdgcn_perm(w1, w0, 0x05040100u); }
DEV unsigned perm_hi(unsigned w1, unsigned w0) { return __builtin_amdgcn_perm(w1, w0, 0x07060302u); }
DEV void phase_fnet_s1(const P& p, LAS unsigned char* lds) {
    const int tid = tid_(), lane = tid & 63, wid = __builtin_amdgcn_readfirstlane(tid >> 6);
    const int gw = (int)blockIdx.x * 8 + wid, GW = (int)gridDim.x * 8;
    const int jj = lane & 31, hh = lane >> 5;
    const bf16_t* F1 = (const bf16_t*)(p.ws + WS_F1); const bf16_t* H = (const bf16_t*)(p.ws + WS_XA);
    const float* PART = (const float*)(p.ws + WS_PART); const float* modl = (const float*)(p.ws + WS_MOD) + 9 * 6144; const float* gain = p.norm_mix + DM;
    LAS float* rsl = (LAS float*)lds + 64 * wid;
    bf16_t* T = (bf16_t*)(p.ws + WS_R + R_T); const float2* TW = (const float2*)(p.ws + WS_TW);
    bf16x8 Af[4][4];
#pragma unroll
    for (int ib = 0; ib < 4; ++ib)
#pragma unroll
        for (int ks = 0; ks < 4; ++ks) Af[ib][ks] = *(const bf16x8*)(F1 + (size_t)(32 * ib + jj) * 64 + 16 * ks + 8 * hh);
    for (int it = gw; it < NB * 64 * 16; it += GW) {
        const int cb = it & 15, n2 = (it >> 4) & 63, b = it >> 10;
        const int col = 64 * cb + 2 * jj;
        const bf16_t* hb = H + ((size_t)b * SEQ + n2) * DM + col;
        { const float* pr = PART + ((size_t)b * SEQ + 64 * lane + n2) * 16;
          const f32x4 a0 = *(const f32x4*)pr, a1 = *(const f32x4*)(pr + 4), a2 = *(const f32x4*)(pr + 8), a3 = *(const f32x4*)(pr + 12);
          const f32x4 a = (a0 + a1) + (a2 + a3);
          rsl[lane] = rsqrtf(((a[0] + a[1]) + (a[2] + a[3])) * (1.0f / 1024.0f) + 1e-6f); }
        const float2 g2 = *(const float2*)(gain + col), sc2 = *(const float2*)(modl + (size_t)b * 6144 + 1024 + col), sh2 = *(const float2*)(modl + (size_t)b * 6144 + col);
        const float gs0 = g2.x * (sc2.x + 1.0f), gs1 = g2.y * (sc2.y + 1.0f);
        __builtin_amdgcn_fence(__ATOMIC_RELEASE, "wavefront"); __builtin_amdgcn_wave_barrier(); __builtin_amdgcn_fence(__ATOMIC_ACQUIRE, "wavefront");
        bf16x8 Bf[2][4];
#pragma unroll
        for (int ks = 0; ks < 4; ++ks) {
            unsigned w[8];
#pragma unroll
            for (int t = 0; t < 8; ++t) w[t] = *(const unsigned*)(hb + (size_t)(64 * (16 * ks + 8 * hh + t)) * DM);
            const f32x4 r0 = *(const LAS f32x4*)(rsl + 16 * ks + 8 * hh), r1 = *(const LAS f32x4*)(rsl + 16 * ks + 8 * hh + 4);
            const float rv[8] = {r0[0], r0[1], r0[2], r0[3], r1[0], r1[1], r1[2], r1[3]};
            float h0[8], h1[8];
#pragma unroll
            for (int t = 0; t < 8; ++t) { h0[t] = bflo(w[t]) * rv[t] * gs0 + sh2.x; h1[t] = bfhi(w[t]) * rv[t] * gs1 + sh2.y; }
            u32x4 e0, e1;
            e0.x = pk_bf16(h0[0], h0[1]); e0.y = pk_bf16(h0[2], h0[3]); e0.z = pk_bf16(h0[4], h0[5]); e0.w = pk_bf16(h0[6], h0[7]);
            e1.x = pk_bf16(h1[0], h1[1]); e1.y = pk_bf16(h1[2], h1[3]); e1.z = pk_bf16(h1[4], h1[5]); e1.w = pk_bf16(h1[6], h1[7]);
            Bf[0][ks] = __builtin_bit_cast(bf16x8, e0); Bf[1][ks] = __builtin_bit_cast(bf16x8, e1);
        }
        __builtin_amdgcn_wave_barrier();
#pragma unroll
        for (int ib2 = 0; ib2 < 2; ++ib2) {
            f32x16 D[2][2];
#pragma unroll
            for (int st = 0; st < 2; ++st)
#pragma unroll
                for (int ri = 0; ri < 2; ++ri) {
#pragma unroll
                    for (int q = 0; q < 16; ++q) D[st][ri][q] = 0.f;
#pragma unroll
                    for (int ks = 0; ks < 4; ++ks) D[st][ri] = __builtin_amdgcn_mfma_f32_32x32x16_bf16(Af[ib2 + 2 * ri][ks], Bf[st][ks], D[st][ri], 0, 0, 0);
                }
            asm volatile("s_nop 15\n\ts_nop 15" ::: "memory");
            __builtin_amdgcn_sched_barrier(0);
#pragma unroll
            for (int r = 0; r < 16; ++r) {
                const int k1 = 32 * ib2 + (r & 3) + 8 * (r >> 2) + 4 * hh;
                const float2 tw = TW[n2 * 64 + k1];
                const float tr0 = D[0][0][r] * tw.x + D[0][1][r] * tw.y, ti0 = D[0][1][r] * tw.x - D[0][0][r] * tw.y;
                const float tr1 = D[1][0][r] * tw.x + D[1][1][r] * tw.y, ti1 = D[1][1][r] * tw.x - D[1][0][r] * tw.y;
                unsigned char* tp = (unsigned char*)T + ((size_t)b * SEQ + k1 * 64 + n2) * 2048 + col;
                *(unsigned short*)tp = (unsigned short)pk2_fp8(tr0, tr1); *(unsigned short*)(tp + 1024) = (unsigned short)pk2_fp8(ti0, ti1);
            }
        }
    }
}
DEV void phase_fnet_s2(const P& p) {
    const int tid = tid_(), lane = tid & 63, wid = __builtin_amdgcn_readfirstlane(tid >> 6);
    const int gw = (int)blockIdx.x * 8 + wid, GW = (int)gridDim.x * 8;
    const int jj = lane & 31, hh = lane >> 5;
    const bf16_t* F2 = (const bf16_t*)(p.ws + WS_F2);
    const bf16_t* T = (const bf16_t*)(p.ws + WS_R + R_T); bf16_t* Y = (bf16_t*)(p.ws + WS_R + R_Y);
    bf16x8 Af[2][8];
#pragma unroll
    for (int ib = 0; ib < 2; ++ib)
#pragma unroll
        for (int ks = 0; ks < 8; ++ks) Af[ib][ks] = *(const bf16x8*)(F2 + (size_t)ib * 64 * 128 + (size_t)jj * 128 + 16 * ks + 8 * hh);
    for (int it = gw; it < NB * 64 * 16; it += GW) {
        const int cb = it & 15, k1 = (it >> 4) & 63, b = it >> 10;
        const int col = 64 * cb + 2 * jj;
        const unsigned char* tb = (const unsigned char*)T + ((size_t)b * SEQ + k1 * 64) * 2048 + col;
        f32x16 D[2][2];
#pragma unroll
        for (int st = 0; st < 2; ++st)
#pragma unroll
            for (int ib = 0; ib < 2; ++ib)
#pragma unroll
                for (int q = 0; q < 16; ++q) D[st][ib][q] = 0.f;
#pragma unroll
        for (int ks = 0; ks < 8; ++ks) {
            unsigned short w[8];
#pragma unroll
            for (int t = 0; t < 8; ++t) { const int kk = 16 * ks + 8 * hh + t; w[t] = *(const unsigned short*)(tb + (size_t)(kk & 63) * 2048 + (kk >> 6) * 1024); }
            f32x2 f[8];
#pragma unroll
            for (int t = 0; t < 8; ++t) f[t] = __builtin_amdgcn_cvt_pk_f32_fp8((int)w[t], false);
            u32x4 e0, e1;
            e0.x = pk_bf16(f[0][0], f[1][0]); e0.y = pk_bf16(f[2][0], f[3][0]); e0.z = pk_bf16(f[4][0], f[5][0]); e0.w = pk_bf16(f[6][0], f[7][0]);
            e1.x = pk_bf16(f[0][1], f[1][1]); e1.y = pk_bf16(f[2][1], f[3][1]); e1.z = pk_bf16(f[4][1], f[5][1]); e1.w = pk_bf16(f[6][1], f[7][1]);
            const bf16x8 b0 = __builtin_bit_cast(bf16x8, e0), b1 = __builtin_bit_cast(bf16x8, e1);
#pragma unroll
            for (int ib = 0; ib < 2; ++ib) { D[0][ib] = __builtin_amdgcn_mfma_f32_32x32x16_bf16(Af[ib][ks], b0, D[0][ib], 0, 0, 0); D[1][ib] = __builtin_amdgcn_mfma_f32_32x32x16_bf16(Af[ib][ks], b1, D[1][ib], 0, 0, 0); }
        }
        asm volatile("s_nop 15\n\ts_nop 15" ::: "memory");
        __builtin_amdgcn_sched_barrier(0);
#pragma unroll
        for (int ib = 0; ib < 2; ++ib)
#pragma unroll
            for (int r = 0; r < 16; ++r) {
                const int k2 = (r & 3) + 8 * (r >> 2) + 4 * hh;
                *(unsigned short*)((unsigned char*)Y + ((size_t)b * 2048 + k1 + 64 * k2) * 2048 + ib * 1024 + col) = (unsigned short)pk2_fp8(D[0][ib][r] * F8_SY, D[1][ib][r] * F8_SY);
            }
        if (k1 == 0 && hh == 0) {
            float a0 = 0.f, a1 = 0.f;
#pragma unroll 8
            for (int n2 = 0; n2 < 64; ++n2) { const f32x2 v = __builtin_amdgcn_cvt_pk_f32_fp8((int)*(const unsigned short*)(tb + (size_t)n2 * 2048), false); a0 += (n2 & 1) ? -v[0] : v[0]; a1 += (n2 & 1) ? -v[1] : v[1]; }
            *(float2*)((float*)(p.ws + WS_Y2048) + b * 1024 + col) = make_float2(a0, a1);
        }
    }
}

constexpr int LDS_BYTES = 144 * 1024;
constexpr int LDS_BARW = 128 * 1024;
constexpr int LDS_TAB = 128 * 1024 + 64;
constexpr int NPHASE = 18;

template <int PH, bool DUMMY = false>
DEV void run_phase(const P& p, LAS unsigned char* lds) {
    void* const dummy_out = (void*)(p.ws + WS_R + 128 * MB_);
    bf16_t* const dummy_out13 = (bf16_t*)(p.ws + WS_R + R_T);
    bf16_t* const XA = (bf16_t*)(p.ws + WS_XA);
    const float* mod0 = (const float*)(p.ws + WS_MOD); const float* mod1 = mod0 + 9 * 6144;
    if constexpr (PH == 0) phase_prologue(p, lds);
    const bool ctx1 = gridDim.x >= CTX_D0 + 48;
    if constexpr (PH == 1) {
        if (ctx1) {
            const int bid = (int)blockIdx.x, dd = bid - CTX_D0;
            unsigned* done = (unsigned*)(p.ws + WS_CNT + 12 * KB_);
            phase_norm_plain<true, false, true>(p, p.x, MTOK, MALL, bid, (int)gridDim.x, p.norm_mix, mod0, 0, 1024);
            asm volatile("s_waitcnt vmcnt(0)" ::: "memory"); __syncthreads();
            if (threadIdx.x == 0) { __builtin_amdgcn_fence(__ATOMIC_RELEASE, "agent"); (void)xb_add(done, 1u); }
            { JobFold J{p}; g8::gemm_phase(lds, J); } phase_mod_final(p);
            if (dd >= 0 && dd < 48) {
                if (threadIdx.x == 0) { unsigned sp = 0; while (xb_ld(done) < gridDim.x && ++sp < XB_SPIN_CAP) __builtin_amdgcn_s_sleep(2); __builtin_amdgcn_fence(__ATOMIC_ACQUIRE, "agent"); }
                __syncthreads();
                const int t = dd >> 3;
                if (t < 2) { JobInProj<false, true> J{p, 2}; g8::gemm_phase(lds, J); } else if (t < 4) { JobInProj<true, true> J{p, 2}; g8::gemm_phase(lds, J); } else { JobInProj<false, false> J{p, 2}; g8::gemm_phase(lds, J); }
            }
            phase_norm_plain<true, false, true>(p, p.x, 0, MTOK, dd < 48 ? -1 : bid - (CTX_D0 + 48), (int)gridDim.x - (CTX_D0 + 48), p.norm_mix, mod0, 0, 1024);
        } else { { JobFold J{p}; g8::gemm_phase(lds, J); } phase_mod_final(p); phase_norm_plain<true, false, true>(p, p.x, 0, MALL, (int)blockIdx.x, (int)gridDim.x, p.norm_mix, mod0, 0, 1024); } }
    if constexpr (PH == 2) { const int md = ctx1 ? 1 : 0; { JobInProj<false, true> J{p, md}; g8::gemm_phase(lds, J); } { JobInProj<true, true> J{p, md}; g8::gemm_phase(lds, J); } { JobInProj<false, false> J{p, md}; g8::gemm_phase(lds, J); } }
    if constexpr (PH == 3) { phase_lru1(p, lds); phase_attention(p, lds); }
    if constexpr (PH == 4) phase_lru_carry(p);
    if constexpr (PH == 5) phase_lru2(p);
    if constexpr (PH == 6) { JobResid<1024, false> J{(const bf16_t*)(p.ws + WS_R + R_MIX), (const bf16_t*)(p.ws + WS_WOUT), p.x, XA, mod0 + 2048}; g8::gemm_phase(lds, J); }
    if constexpr (PH == 7) phase_norm_router(p, lds, XA, p.norm_ffn, mod0, DUMMY ? 2 : 0);
    if constexpr (PH == 8) { moe_build_tab((const unsigned*)(p.ws + WS_CNT), (LAS MoeTab*)(lds + LDS_TAB));
        { JobGateUp J{p, 0, (const LAS MoeTab*)(lds + LDS_TAB)}; g8::gemm_phase(lds, J); }
        { JobDown<false> J{p, 0, (const LAS MoeTab*)(lds + LDS_TAB), DUMMY ? dummy_out : (void*)XA}; g8::gemm_phase(lds, J); } }
    if constexpr (PH == 9) { }
    if constexpr (PH == 10) { }
    if constexpr (PH == 11) phase_fnet_s1(p, lds);
    if constexpr (PH == 12) phase_fnet_s2(p);
    if constexpr (PH == 13) { { JobHerm<0> J{p, XA}; g8::gemm_phase(lds, J); } asm volatile("s_waitcnt vmcnt(0)" ::: "memory"); __syncthreads(); { JobHerm<1> J{p, XA}; g8::gemm_phase(lds, J); } phase_herm_row2048(p, lds, XA); }
    if constexpr (PH == 14) { }
    if constexpr (PH == 15) phase_norm_router(p, lds, XA, p.norm_ffn + DM, mod1, DUMMY ? 3 : 1);
    if constexpr (PH == 16) { moe_build_tab((const unsigned*)(p.ws + WS_CNT) + 1024, (LAS MoeTab*)(lds + LDS_TAB));
        { JobGateUp J{p, 1, (const LAS MoeTab*)(lds + LDS_TAB)}; g8::gemm_phase(lds, J); }
        { JobDown<true> J{p, 1, (const LAS MoeTab*)(lds + LDS_TAB), DUMMY ? dummy_out : (void*)p.out}; g8::gemm_phase(lds, J); } }
    if constexpr (PH == 17) { }
}

#if MK_MULTI
template <int PH> __global__ void __launch_bounds__(NTHREADS, 2) k_phase(P p) {
    extern __shared__ __attribute__((aligned(16))) unsigned char shm[];
    run_phase<PH>(p, (LAS unsigned char*)shm);
}
template <int PH> static void launch_one(const P& p, int grid, hipStream_t s) {
    static bool attr = false; if (!attr) { (void)hipFuncSetAttribute((const void*)k_phase<PH>, hipFuncAttributeMaxDynamicSharedMemorySize, LDS_BYTES); attr = true; }
    hipLaunchKernelGGL((k_phase<PH>), dim3(grid), dim3(NTHREADS), LDS_BYTES, s, p);
}
template <int PH> static void launch_all(const P& p, int grid, hipStream_t s) { launch_one<PH>(p, grid, s); if constexpr (PH + 1 < NPHASE && PH < MK_LAST_PHASE) launch_all<PH + 1>(p, grid, s); }
#else
DEV P load_params() {
    typedef const unsigned long long __attribute__((address_space(4))) * KP;
    KP pp = (KP)__builtin_amdgcn_kernarg_segment_ptr();
    asm volatile("" : "+s"(pp));
    P r;
    typedef const float __attribute__((address_space(1))) * GF; typedef float __attribute__((address_space(1))) * GFW; typedef unsigned char __attribute__((address_space(1))) * GB;
#define LP_(i, f) r.f = (const float*)(GF)pp[i]
    LP_(0, x); LP_(1, c); LP_(2, ctx); LP_(3, c_ctx); LP_(4, ada_w); LP_(5, ada_b); LP_(6, norm_mix); LP_(7, norm_ffn); LP_(8, mix_w_in); LP_(9, mix_w_out); LP_(10, qn); LP_(11, kn); LP_(12, rpb);
    LP_(13, conv_w); LP_(14, conv_b); LP_(15, gr_w); LP_(16, gr_b); LP_(17, gi_w); LP_(18, gi_b); LP_(19, lam); LP_(20, fnet_w); LP_(21, router_w); LP_(22, router_b); LP_(23, wg); LP_(24, wu); LP_(25, wd);
#undef LP_
    r.out = (float*)(GFW)pp[26]; r.ws = (unsigned char*)(GB)pp[27];
    return r;
}
template <int PH> DEV void run_all(LAS unsigned char* lds) {
#ifdef MK_REP_MASK
    if constexpr (((MK_REP_MASK) >> PH) & 1) {
        { const P p = load_params(); run_phase<PH, true>(p, lds); }
        { const P pb = load_params(); XcdBarrier bar; bar.bar = (unsigned*)(pb.ws + WS_BAR); bar.x = xb_xcc_id(); bar.st = (volatile LAS unsigned*)(lds + LDS_BARW); xcd_barrier(bar); }
    }
#endif
    { const P p = load_params(); run_phase<PH>(p, lds); }
    if constexpr (PH + 1 < NPHASE && PH < MK_LAST_PHASE) {
        if constexpr (PH != 13 && PH != 9 && PH != 8 && PH != 16) { const P pb = load_params();
          XcdBarrier bar; bar.bar = (unsigned*)(pb.ws + WS_BAR); bar.x = xb_xcc_id(); bar.st = (volatile LAS unsigned*)(lds + LDS_BARW);
          xcd_barrier(bar); }
        run_all<PH + 1>(lds);
    }
}
__global__ void __launch_bounds__(NTHREADS, 2) k_mega(P p) {
    extern __shared__ __attribute__((aligned(16))) unsigned char shm[];
    LAS unsigned char* lds = (LAS unsigned char*)shm;
    if (threadIdx.x == 0) *(LAS u32x4*)(lds + LDS_BARW) = (u32x4){0u, 0u, 0u, 0u};
    __syncthreads();
    (void)xcd_barrier_post((unsigned*)(p.ws + WS_BAR), (volatile LAS unsigned*)(lds + LDS_BARW));
    run_all<0>(lds);
}
#endif

extern "C" void kernel_launch(void* const* d_in, const int* in_sizes, int n_in, void* d_out, int out_size, void* d_ws, size_t ws_size, hipStream_t stream) {
    static int grid = 0;
    if (grid == 0) {
        if (n_in != 26 || out_size != MTOK * DM || ws_size < WS_END) { fprintf(stderr, "kernel_launch: unexpected problem (n_in %d out %d ws %zu need %zu)\n", n_in, out_size, ws_size, (size_t)WS_END); grid = -1; return; }
        int dev = 0, cus = 0; (void)hipGetDevice(&dev); (void)hipDeviceGetAttribute(&cus, hipDeviceAttributeMultiprocessorCount, dev);
#if !MK_MULTI
        if (hipFuncSetAttribute((const void*)k_mega, hipFuncAttributeMaxDynamicSharedMemorySize, LDS_BYTES) != hipSuccess) { fprintf(stderr, "kernel_launch: hipFuncSetAttribute failed\n"); grid = -1; return; }
        int per_cu = 0; (void)hipOccupancyMaxActiveBlocksPerMultiprocessor(&per_cu, (const void*)k_mega, NTHREADS, LDS_BYTES);
        if (per_cu < 1) { fprintf(stderr, "kernel_launch: occupancy query says %d blocks per CU\n", per_cu); }
#endif
        grid = cus > 0 ? (cus / 8) * 8 : 256; if (grid < 8) grid = 8;
    }
    if (grid < 0) return;
    P p{};
    const float** f = (const float**)&p;
    for (int i = 0; i < 26; ++i) f[i] = (const float*)d_in[i];
    p.out = (float*)d_out; p.ws = (unsigned char*)d_ws;
    (void)hipMemsetAsync(d_ws, 0, WS_ZERO_BYTES, stream);
#if MK_MULTI
    launch_all<0>(p, grid, stream);
#else
    hipLaunchKernelGGL(k_mega, dim3(grid), dim3(NTHREADS), LDS_BYTES, stream, p);
#endif
}
```

```cpp
#include <hip/hip_runtime.h>
#include <stdint.h>
#include <stdio.h>

#ifndef MK_MULTI
#define MK_MULTI 0
#endif

#ifndef MK_LAST_PHASE
#define MK_LAST_PHASE 17
#endif
#define DEV __device__ __forceinline__
#define LAS __attribute__((address_space(3)))
typedef unsigned short bf16_t;
typedef short bf16x8 __attribute__((ext_vector_type(8)));
typedef float f32x2 __attribute__((ext_vector_type(2)));
typedef float f32x4 __attribute__((ext_vector_type(4)));
typedef float f32x16 __attribute__((ext_vector_type(16)));
typedef unsigned u32x4 __attribute__((ext_vector_type(4)));
typedef unsigned u32x2 __attribute__((ext_vector_type(2)));
typedef int i32x8 __attribute__((ext_vector_type(8)));
typedef int i32x4 __attribute__((ext_vector_type(4)));

constexpr int DM = 1024, NB = 8, SEQ = 4096, MTOK = NB * SEQ, CTXL = 256, MCTX = NB * CTXL, MALL = MTOK + MCTX;
constexpr int NPAIR = 24, LISTCAP = 32768, HIDROWS = 38912;
constexpr float LOG2E = 1.4426950408889634f;
constexpr int NTHREADS = 512;

constexpr size_t KB_ = 1024, MB_ = 1024 * 1024;
constexpr size_t WS_BAR   = 0;
constexpr size_t WS_CNT   = 16 * KB_;
constexpr size_t WS_MOD   = 64 * KB_;
constexpr size_t WS_ZERO_BYTES = 512 * KB_;
constexpr size_t WS_RPB2  = 512 * KB_;
constexpr size_t WS_LA8   = WS_RPB2 + 16 * KB_;
constexpr size_t WS_F1    = WS_LA8 + 4 * KB_;
constexpr size_t WS_F2    = WS_F1 + 16 * KB_;
constexpr size_t WS_TW    = WS_F2 + 32 * KB_;
constexpr size_t WS_CS    = WS_TW + 32 * KB_;
constexpr size_t WS_WGT   = WS_CS + 256 * KB_;
constexpr size_t WS_Y2048 = 1536 * KB_;
constexpr size_t WS_WIN   = 2 * MB_;
constexpr size_t WS_WOUT  = WS_WIN + 5 * MB_;
constexpr size_t WS_WF    = WS_WOUT + 2 * MB_;
constexpr size_t WS_WFOLD = WS_WF + 2 * MB_;
constexpr size_t WS_WGU   = WS_WFOLD + 4 * MB_;
constexpr size_t WS_WD    = WS_WGU + 64 * MB_;
constexpr size_t WS_PART  = WS_WD + 16 * MB_;
constexpr size_t WS_H     = WS_WD + 32 * MB_;
constexpr size_t WS_LIST  = WS_H + 68 * MB_;
constexpr size_t WS_SLOTW = WS_LIST + 3 * MB_;
constexpr size_t WS_R     = WS_SLOTW + 6 * MB_;
constexpr size_t WS_SUM   = WS_R + 256 * MB_;
constexpr size_t WS_CAR   = WS_SUM + 9 * MB_;
constexpr size_t WS_MODP  = WS_CAR + 4 * MB_;
constexpr size_t WS_XA    = WS_SUM;
constexpr size_t WS_END   = WS_XA + 64 * MB_;
constexpr size_t R_Q = 0, R_K = 32 * MB_, R_VT = 64 * MB_, R_XB = 96 * MB_, R_GB = 128 * MB_, R_KC = 160 * MB_, R_VCT = 162 * MB_, R_XBC = 164 * MB_, R_MIX = 166 * MB_;
constexpr size_t R_T = 0, R_Y = 128 * MB_;
constexpr size_t R_P = 0;
constexpr size_t R_HID = 0;

struct P {
    const float *x, *c, *ctx, *c_ctx, *ada_w, *ada_b, *norm_mix, *norm_ffn, *mix_w_in, *mix_w_out, *qn, *kn, *rpb, *conv_w, *conv_b,
                *gr_w, *gr_b, *gi_w, *gi_b, *lam, *fnet_w, *router_w, *router_b, *wg, *wu, *wd;
    float* out; unsigned char* ws;
};

typedef __bf16 bf16v2_ __attribute__((ext_vector_type(2)));
typedef float f32v2_ __attribute__((ext_vector_type(2)));
DEV unsigned pk_bf16(float lo, float hi) { const f32v2_ v = {lo, hi}; const bf16v2_ b = __builtin_convertvector(v, bf16v2_); return __builtin_bit_cast(unsigned, b); }
DEV unsigned pk_bf16_asm(float lo, float hi) { unsigned r; asm("v_cvt_pk_bf16_f32 %0, %1, %2" : "=v"(r) : "v"(lo), "v"(hi)); return r; }
DEV bf16_t f2bf(float f) { return (bf16_t)(pk_bf16(f, 0.f) & 0xffffu); }
DEV float bf2f(bf16_t b) { return __uint_as_float(((unsigned)b) << 16); }
DEV float bflo(unsigned w) { return __uint_as_float(w << 16); }
DEV float bfhi(unsigned w) { return __uint_as_float(w & 0xffff0000u); }
DEV float sigmoidf_(float z) { return __builtin_amdgcn_rcpf(1.0f + __builtin_amdgcn_exp2f(-LOG2E * z)); }
DEV float gelu_tanh(float x) { const float u = 0.7978845608028654f * (x + 0.044715f * x * x * x); return x * __builtin_amdgcn_rcpf(1.0f + __builtin_amdgcn_exp2f(-2.0f * LOG2E * u)); }
DEV float clamp448(float v) { return fminf(fmaxf(v, -448.0f), 448.0f); }
DEV unsigned pk4_fp8(float a, float b, float c, float d) { unsigned w = 0u; w = (unsigned)__builtin_amdgcn_cvt_pk_fp8_f32(clamp448(a), clamp448(b), (int)w, false); w = (unsigned)__builtin_amdgcn_cvt_pk_fp8_f32(clamp448(c), clamp448(d), (int)w, true); return w; }
constexpr float F8_SH = 8.0f, F8_SW = 64.0f, F8_SHID = 8.0f;
constexpr float F8_SY = 0.0625f, F8_SWF = 32768.0f;
DEV unsigned pk2_fp8(float a, float b) { return (unsigned)__builtin_amdgcn_cvt_pk_fp8_f32(clamp448(a), clamp448(b), 0, false) & 0xffffu; }
DEV int clampi(int v, int lo, int hi) { return v < lo ? lo : (v > hi ? hi : v); }
DEV int l8row(int c) { return (c & ~31) + 16 * ((c >> 2) & 1) + 4 * ((c >> 3) & 3) + (c & 3); }
DEV int tid_() { int t = (int)threadIdx.x; asm volatile("" : "+v"(t)); return t; }

#define XB_TMO      128
#define XB_XCNT(j)  (256  + 64 * (j))
#define XB_XSUB(j)  (1280 + 64 * (j))
#define XB_XGEN(j)  (2304 + 64 * (j))
#define XB_TOP      3328
#define XB_TOPGEN   3392
#define XCD_BAR_WORDS 3456
#define XB_SPIN_CAP (1u << 22)
DEV unsigned xb_ld(unsigned* p)              { return __hip_atomic_load(p, __ATOMIC_RELAXED, __HIP_MEMORY_SCOPE_AGENT); }
DEV unsigned xb_add(unsigned* p, unsigned v) { return __hip_atomic_fetch_add(p, v, __ATOMIC_RELAXED, __HIP_MEMORY_SCOPE_AGENT); }
DEV unsigned xb_xcc_id() { return (unsigned)__builtin_amdgcn_s_getreg((3 << 11) | 20) & 0xFu; }
#define XB_SPIN(cond, bar) do { unsigned _sp = 0; while (cond) { __builtin_amdgcn_s_sleep(1); \
    if ((++_sp & 255u) == 0u) { if (xb_ld(&(bar)[XB_TMO])) break; if (_sp > XB_SPIN_CAP) { atomicAdd(&(bar)[XB_TMO], 1u); break; } } } } while (0)
struct XcdBarrier { unsigned* bar; unsigned x; volatile LAS unsigned* st; };
DEV XcdBarrier xcd_barrier_post(unsigned* bar, volatile LAS unsigned* st) {
    XcdBarrier b; b.bar = bar; b.x = xb_xcc_id(); b.st = st;
    if (threadIdx.x == 0) (void)xb_add(&bar[XB_XCNT(b.x)], 1u);
    return b;
}
DEV void xcd_barrier_complete(unsigned* bar, unsigned x, unsigned& nloc, unsigned& nx) {
    const unsigned G = gridDim.x * gridDim.y * gridDim.z;
    unsigned sum, cnt, mine, sp = 0u;
    for (;;) {
        sum = 0u; cnt = 0u; mine = 0u;
#pragma unroll
        for (unsigned j = 0; j < 16; ++j) { const unsigned c = xb_ld(&bar[XB_XCNT(j)]); sum += c; cnt += (c > 0u) ? 1u : 0u; mine = (j == x) ? c : mine; }
        if (sum == G) break;
        __builtin_amdgcn_s_sleep(1);
        if ((++sp & 255u) == 0u) { if (xb_ld(&bar[XB_TMO])) break; if (sp > XB_SPIN_CAP) { atomicAdd(&bar[XB_TMO], 1u); break; } }
    }
    nloc = mine > 0u ? mine : 1u; nx = cnt > 0u ? cnt : 1u;
}
DEV void xcd_barrier(const XcdBarrier& b) {
    asm volatile("s_waitcnt vmcnt(0)" ::: "memory");
    __syncthreads();
    if (threadIdx.x == 0) {
        unsigned* bar = b.bar;
        __builtin_amdgcn_s_waitcnt(0);
        unsigned nloc = b.st[0], nx = b.st[1];
        if (nloc == 0u) { xcd_barrier_complete(bar, b.x, nloc, nx); b.st[0] = nloc; b.st[1] = nx; }
        const unsigned old = xb_add(&bar[XB_XSUB(b.x)], 1u);
        const unsigned gen = old / nloc;
        if (old + 1u == (gen + 1u) * nloc) {
            __builtin_amdgcn_fence(__ATOMIC_RELEASE, "agent");
            asm volatile("s_waitcnt vmcnt(0)" ::: "memory");
            const unsigned og = xb_add(&bar[XB_TOP], 1u);
            const unsigned tg = og / nx;
            if (og + 1u == (tg + 1u) * nx) xb_add(&bar[XB_TOPGEN], 1u);
            else XB_SPIN(xb_ld(&bar[XB_TOPGEN]) == tg, bar);
            __builtin_amdgcn_fence(__ATOMIC_ACQUIRE, "agent");
            xb_add(&bar[XB_XGEN(b.x)], 1u);
            asm volatile("s_waitcnt vmcnt(0)" ::: "memory");
        } else {
            XB_SPIN(xb_ld(&bar[XB_XGEN(b.x)]) == gen, bar);
            __builtin_amdgcn_fence(__ATOMIC_ACQUIRE, "agent");
            asm volatile("s_waitcnt vmcnt(0)" ::: "memory");
        }
    }
    __syncthreads();
}

namespace g8 {
constexpr int BM = 256, BK = 64, HALF = 128, HTB = HALF * BK * 2, STAGE_BYTES = 8 * HTB;
DEV int lds_byte(int r, int c) { const int st = (r >> 4) * 2 + (c >> 5), rr = r & 15, cc = c & 31, ob = rr * 64 + cc * 2; return st * 1024 + (ob ^ (((ob >> 9) & 1) << 5)); }
DEV void stage_rc(int b, int& R, int& C) { const int st = b / 1024, sb = b % 1024, swz = sb ^ (((sb >> 9) & 1) << 5); R = (st >> 1) * 16 + swz / 64; C = (st & 1) * 32 + (swz % 64) / 2; }

struct UCtx {
    const char* A; const char* B0; const char* B1;
    unsigned aoff[2][2];
    int i0, i1, i2, i3, i4;
    int swap;
};

template <class Job>
DEV void gemm_phase(LAS unsigned char* lds, const Job& J) {
    const int tid = tid_(), wid = __builtin_amdgcn_readfirstlane(tid >> 6), lane = tid & 63, wr = wid >> 2, wc = wid & 3, fr = lane & 15, fq = lane >> 4;
    constexpr int ESZ = Job::FP8 ? 1 : 2;
    constexpr int K = Job::K, nt = K * ESZ / 128, KSPLIT = Job::KSPLIT, LDB = Job::LDB;
    int Rr[2], Cc[2]; unsigned voffB[2];
#pragma unroll
    for (int i = 0; i < 2; ++i) { int R, C; stage_rc(tid * 16 + i * 8192, R, C); Rr[i] = R; Cc[i] = C; voffB[i] = (unsigned)(R * LDB * ESZ + C * 2); }
    constexpr size_t kstep = (size_t)(BK * 2);
    constexpr size_t hstepB = (size_t)HALF * LDB * ESZ;
    const unsigned ldsw = (unsigned)wid * 1024u;
    const int aoff = lds_byte(wr * 64 + fr, fq * 8), boff = lds_byte(wc * 32 + fr, fq * 8);
#define G8_SA(b, h) (((b) * 2 + (h)) * HTB)
#define G8_SB(b, h) ((4 + (b) * 2 + (h)) * HTB)
#define G8_STAGE_A(bufoff, cx, h, tb) do { _Pragma("unroll") for (int _i = 0; _i < 2; ++_i) \
        __builtin_amdgcn_raw_ptr_buffer_load_lds(rsrcA, (LAS unsigned*)(lds + (bufoff) + ldsw + _i * 8192), 16, (int)(cx).aoff[h][_i], (int)(tb), 0, 0); } while (0)
#define G8_STAGE_B(bufoff, bp, h) do { _Pragma("unroll") for (int _i = 0; _i < 2; ++_i) \
        __builtin_amdgcn_raw_ptr_buffer_load_lds(rsrcB, (LAS unsigned*)(lds + (bufoff) + ldsw + _i * 8192), 16, (int)voffB[_i], (int)((unsigned)((bp) - bbase) + (unsigned)((h) * hstepB)), 0, 0); } while (0)
#define G8_BT(cx, t) (((t) < KSPLIT) ? (cx).B0 + (size_t)(t) * kstep : (cx).B1 + (size_t)((t) - KSPLIT) * kstep)
#define G8_LDA(dst, b, h) do { if constexpr (Job::FP8) { _Pragma("unroll") for (int m = 0; m < 4; ++m) { const i32x4 lo_ = *(const LAS i32x4*)(lds + G8_SA(b, h) + aoff + m * 2048), hi_ = *(const LAS i32x4*)(lds + G8_SA(b, h) + aoff + m * 2048 + 1024); \
            dst##8[m] = __builtin_shufflevector(lo_, hi_, 0, 1, 2, 3, 4, 5, 6, 7); } } \
        else { _Pragma("unroll") for (int m = 0; m < 4; ++m) _Pragma("unroll") for (int k = 0; k < 2; ++k) dst[m][k] = *(const LAS bf16x8*)(lds + G8_SA(b, h) + aoff + m * 2048 + k * 1024); } } while (0)
#define G8_LDB(dst, b, h) do { if constexpr (Job::FP8) { _Pragma("unroll") for (int n = 0; n < 2; ++n) { const i32x4 lo_ = *(const LAS i32x4*)(lds + G8_SB(b, h) + boff + n * 2048), hi_ = *(const LAS i32x4*)(lds + G8_SB(b, h) + boff + n * 2048 + 1024); \
            dst##8[n] = __builtin_shufflevector(lo_, hi_, 0, 1, 2, 3, 4, 5, 6, 7); } } \
        else { _Pragma("unroll") for (int n = 0; n < 2; ++n) _Pragma("unroll") for (int k = 0; k < 2; ++k) dst[n][k] = *(const LAS bf16x8*)(lds + G8_SB(b, h) + boff + n * 2048 + k * 1024); } } while (0)
#define G8_MMA(ai, bj, At, Bt) do { __builtin_amdgcn_s_setprio(1); \
        if constexpr (Job::FP8) { _Pragma("unroll") for (int m = 0; m < 4; ++m) _Pragma("unroll") for (int n = 0; n < 2; ++n) \
            { if constexpr (Job::SWAPPED) asm volatile("v_mfma_f32_16x16x128_f8f6f4 %0, %1, %2, %0" : "+v"(acc[ai][bj][m][n]) : "v"(At##8[m]), "v"(Bt##8[n])); \
              else asm volatile("v_mfma_f32_16x16x128_f8f6f4 %0, %1, %2, %0" : "+v"(acc[ai][bj][m][n]) : "v"(Bt##8[n]), "v"(At##8[m])); } } \
        else if constexpr (Job::SWAPPED) { _Pragma("unroll") for (int m = 0; m < 4; ++m) _Pragma("unroll") for (int n = 0; n < 2; ++n) _Pragma("unroll") for (int k = 0; k < 2; ++k) \
            acc[ai][bj][m][n] = __builtin_amdgcn_mfma_f32_16x16x32_bf16(At[m][k], Bt[n][k], acc[ai][bj][m][n], 0, 0, 0); } \
        else { _Pragma("unroll") for (int m = 0; m < 4; ++m) _Pragma("unroll") for (int n = 0; n < 2; ++n) _Pragma("unroll") for (int k = 0; k < 2; ++k) \
            acc[ai][bj][m][n] = __builtin_amdgcn_mfma_f32_16x16x32_bf16(Bt[n][k], At[m][k], acc[ai][bj][m][n], 0, 0, 0); } \
        __builtin_amdgcn_s_setprio(0); } while (0)
#define G8_WAIT_V(n) asm volatile("s_waitcnt vmcnt(" #n ")" ::: "memory")
#define G8_WAIT_L(n) asm volatile("s_waitcnt lgkmcnt(" #n ")" ::: "memory")
#define G8_BAR __builtin_amdgcn_s_barrier()
#define G8_SCHED __builtin_amdgcn_sched_barrier(0)
    UCtx cur, nxt; int ui = 0; unsigned* pend = nullptr;
    if (!J.get(0, cur, Rr, Cc)) return;
#define G8_DEPWAIT(cx) do { if constexpr (Job::SYNC == 2) { if (tid == 0) { unsigned* tc_ = J.tile_counter(cx); unsigned sp_ = 0; while (xb_ld(tc_) < 8u && ++sp_ < XB_SPIN_CAP) __builtin_amdgcn_s_sleep(2); \
            __builtin_amdgcn_fence(__ATOMIC_ACQUIRE, "agent"); } __syncthreads(); } } while (0)
    G8_DEPWAIT(cur);
    const char* const bbase = J.bbase();
    const __amdgpu_buffer_rsrc_t rsrcA = __builtin_amdgcn_make_buffer_rsrc((void*)cur.A, 0, 0x7fffffff, 0x00020000);
    const __amdgpu_buffer_rsrc_t rsrcB = __builtin_amdgcn_make_buffer_rsrc((void*)bbase, 0, 0x7fffffff, 0x00020000);
    f32x4 acc[2][2][4][2];
#pragma unroll
    for (int a = 0; a < 2; ++a)
#pragma unroll
        for (int b = 0; b < 2; ++b)
#pragma unroll
            for (int m = 0; m < 4; ++m)
#pragma unroll
                for (int n = 0; n < 2; ++n) acc[a][b][m][n] = (f32x4){0.f, 0.f, 0.f, 0.f};
    bf16x8 At[4][2], B0[2][2], B1[2][2];
    i32x8 At8[4], B08[2], B18[2];
    { const char* b0 = G8_BT(cur, 0); const char* b1 = G8_BT(cur, 1);
      G8_STAGE_B(G8_SB(0, 0), b0, 0); G8_STAGE_B(G8_SB(0, 1), b0, 1); G8_STAGE_A(G8_SA(0, 0), cur, 0, 0); G8_STAGE_A(G8_SA(0, 1), cur, 1, 0);
      if (wr == 1) G8_BAR;
      G8_WAIT_V(2); G8_BAR;
      G8_STAGE_B(G8_SB(1, 0), b1, 0); G8_STAGE_A(G8_SA(1, 0), cur, 0, kstep); G8_STAGE_B(G8_SB(1, 1), b1, 1);
      G8_WAIT_V(6); G8_BAR; }
    for (;;) {
        const bool has_next = J.get(ui + 1, nxt, Rr, Cc);
        if (has_next) G8_DEPWAIT(nxt);
        if (!has_next) { nxt.A = cur.A; nxt.B0 = cur.B0; nxt.B1 = cur.B1; nxt.aoff[0][0] = cur.aoff[0][0]; nxt.aoff[0][1] = cur.aoff[0][1]; nxt.aoff[1][0] = cur.aoff[1][0]; nxt.aoff[1][1] = cur.aoff[1][1]; }
        for (int t = 0; t < nt; t += 2) {
            const bool last = (t == nt - 2);
            const int t2 = last ? 0 : t + 2, t3 = last ? 1 : t + 3;
            const char* b2 = last ? G8_BT(nxt, t2) : G8_BT(cur, t2); const char* b3 = last ? G8_BT(nxt, t3) : G8_BT(cur, t3);
            struct { const char* A; unsigned aoff[2][2]; } c2;
            c2.A = last ? nxt.A : cur.A;
            c2.aoff[0][0] = last ? nxt.aoff[0][0] : cur.aoff[0][0]; c2.aoff[0][1] = last ? nxt.aoff[0][1] : cur.aoff[0][1];
            c2.aoff[1][0] = last ? nxt.aoff[1][0] : cur.aoff[1][0]; c2.aoff[1][1] = last ? nxt.aoff[1][1] : cur.aoff[1][1];
            const size_t a1b = (size_t)(t + 1) * kstep, a2b = (size_t)t2 * kstep, a3b = (size_t)t3 * kstep;
            G8_LDB(B0, 0, 0); G8_LDB(B1, 0, 1); G8_SCHED; G8_LDA(At, 0, 0); G8_STAGE_A(G8_SA(1, 1), cur, 1, a1b);
            G8_WAIT_V(8); G8_WAIT_L(0); G8_BAR; G8_MMA(0, 0, At, B0); G8_MMA(0, 1, At, B1); G8_BAR; G8_SCHED;
            G8_LDA(At, 0, 1); G8_STAGE_B(G8_SB(0, 0), b2, 0); G8_STAGE_B(G8_SB(0, 1), b2, 1); G8_STAGE_A(G8_SA(0, 0), c2, 0, a2b);
            G8_WAIT_V(8); G8_WAIT_L(0); G8_BAR; G8_MMA(1, 0, At, B0); G8_MMA(1, 1, At, B1); G8_BAR; G8_SCHED;
            G8_LDB(B0, 1, 0); G8_LDB(B1, 1, 1); G8_SCHED; G8_LDA(At, 1, 0); G8_STAGE_A(G8_SA(0, 1), c2, 1, a2b);
            G8_WAIT_V(8); G8_WAIT_L(0); G8_BAR; G8_MMA(0, 0, At, B0); G8_MMA(0, 1, At, B1); G8_BAR; G8_SCHED;
            G8_LDA(At, 1, 1); G8_STAGE_B(G8_SB(1, 0), b3, 0); G8_STAGE_B(G8_SB(1, 1), b3, 1); G8_STAGE_A(G8_SA(1, 0), c2, 0, a3b);
            G8_WAIT_V(8); G8_WAIT_L(0); G8_BAR; G8_MMA(1, 0, At, B0); G8_MMA(1, 1, At, B1); G8_BAR; G8_SCHED;
        }
        if (wr == 0) G8_BAR;
        if constexpr (Job::FP8) asm volatile("s_nop 15\n\ts_nop 7" ::: "memory");
        if constexpr (Job::SYNC == 1) {
            if (pend != nullptr && tid == 0) (void)xb_add(pend, 1u);
        }
        J.epi(acc, cur, wr, wc, fr, fq);
        if constexpr (Job::SYNC == 1) {
            if (has_next) pend = J.tile_counter(cur);
            else { asm volatile("s_waitcnt vmcnt(0)" ::: "memory"); __syncthreads(); if (tid == 0) (void)xb_add(J.tile_counter(cur), 1u); }
        }
        if (!has_next) break;
#pragma unroll
        for (int a = 0; a < 2; ++a)
#pragma unroll
            for (int b = 0; b < 2; ++b)
#pragma unroll
                for (int m = 0; m < 4; ++m)
#pragma unroll
                    for (int n = 0; n < 2; ++n) acc[a][b][m][n] = (f32x4){0.f, 0.f, 0.f, 0.f};
        cur.A = nxt.A; cur.B0 = nxt.B0; cur.B1 = nxt.B1; cur.aoff[0][0] = nxt.aoff[0][0]; cur.aoff[0][1] = nxt.aoff[0][1]; cur.aoff[1][0] = nxt.aoff[1][0]; cur.aoff[1][1] = nxt.aoff[1][1];
        cur.i0 = nxt.i0; cur.i1 = nxt.i1; cur.i2 = nxt.i2; cur.i3 = nxt.i3; cur.i4 = nxt.i4; cur.swap = nxt.swap; ++ui;
        if (wr == 1) G8_BAR;
    }
    G8_WAIT_V(0);
    G8_BAR;
#undef G8_DEPWAIT
#undef G8_SA
#undef G8_SB
#undef G8_STAGE_A
#undef G8_STAGE_B
#undef G8_BT
#undef G8_LDA
#undef G8_LDB
#undef G8_MMA
#undef G8_WAIT_V
#undef G8_WAIT_L
#undef G8_BAR
#undef G8_SCHED
}
}
using g8::UCtx;

DEV bool deal(int i, int nPanels, int nN, int& pm, int& pn, bool rev = false) {
    const int G = (int)gridDim.x, bid = (int)blockIdx.x;
    if ((G & 7) == 0) {
        const int x = bid & 7, W = G >> 3, w = rev ? W - 1 - (bid >> 3) : (bid >> 3);
        const int v = w + W * i, j = v / nN; pn = v - j * nN; pm = x + 8 * j;
        return pm < nPanels;
    } else {
        const int v = (rev ? G - 1 - bid : bid) + G * i; pm = v / nN; pn = v - pm * nN; return pm < nPanels;
    }
}

constexpr int CTX_D0 = 32;
template <bool VT, bool F8>
struct JobInProj {
    static constexpr int K = 1024, LDB = 1024, KSPLIT = F8 ? 8 : 16, SWAPPED = VT ? 1 : 0, FP8 = F8 ? 1 : 0; static constexpr int SYNC = 0;
    P p; int mode;
    DEV const char* bbase() const { return (const char*)(p.ws + WS_WIN) + (F8 ? 0 : 2 * MB_); }
    DEV bool get(int i, UCtx& c, const int (&Rr)[2], const int (&Cc)[2]) const {
        const int G = (int)gridDim.x, bid = (int)blockIdx.x; int pm, pn;
        const int x = bid & 7, W = G >> 3;
        if (mode == 2) { if (i) return false; pm = 128 + x; pn = 2 + ((bid - CTX_D0) >> 3); }
        else if constexpr (!VT && F8) {
            const int w = bid >> 3, v = w + W * i;
            if (v < 64) { pm = x + 8 * (v >> 2); pn = v & 3; }
            else if (v < 66 && mode == 0) { pm = 128 + x; pn = 2 + (v - 64); }
            else return false;
        } else if constexpr (VT) {
            const int w = W - 1 - (bid >> 3), v = w + W * i;
            if (v < 32) { pm = x + 8 * (v >> 1); pn = 4 + (v & 1); }
            else if (v < 34 && mode == 0) { pm = 128 + x; pn = 4 + (v - 32); }
            else return false;
        } else {
            const int w = ((bid >> 3) + (W >> 1)) % W, v = w + W * i;
            if (v < 64) { pm = x + 8 * (v >> 2); pn = 6 + (v & 3); }
            else if (v < 66 && mode == 0) { pm = 128 + x; pn = 6 + (v - 64); }
            else return false;
        }
        if constexpr (F8) { c.A = (const char*)p.out; c.B0 = (const char*)(p.ws + WS_WIN) + (size_t)(256 * pn) * LDB; }
        else { c.A = (const char*)(p.ws + WS_H); c.B0 = (const char*)(p.ws + WS_WIN) + 2 * MB_ + (size_t)(256 * (pn - 6)) * LDB * 2; }
        c.B1 = c.B0;
#pragma unroll
        for (int h = 0; h < 2; ++h)
#pragma unroll
            for (int k = 0; k < 2; ++k) c.aoff[h][k] = F8 ? (unsigned)((256 * pm + 128 * h + Rr[k]) * K + Cc[k] * 2) : (unsigned)((256 * pm + 128 * h + Rr[k]) * K + Cc[k]) * 2u;
        c.i0 = pm; c.i1 = pn; c.i2 = 0; c.i3 = 0; c.i4 = 0; c.swap = (pn == 4 || pn == 5) ? 1 : 0;
        return true;
    }
    DEV void epi(const f32x4 (&acc)[2][2][4][2], const UCtx& c, int wr, int wc, int fr, int fq) const {
        constexpr float ISC = F8 ? 1.0f / (F8_SH * F8_SW) : 1.0f;
        const int pm = c.i0, pn = c.i1; const bool isctx = pm >= 128;
        unsigned char* R = p.ws + WS_R;
        const int rowbase = isctx ? (256 * pm - MTOK) : 256 * pm;
        if constexpr (!VT) { if constexpr (F8) {
            const bool isq = pn < 2; const int head = 4 * (pn & 1) + wc;
            const float* gn = isq ? p.qn : p.kn; const float osc = isq ? 0.125f * LOG2E : 1.0f;
            f32x4 g[2][2];
#pragma unroll
            for (int bj = 0; bj < 2; ++bj)
#pragma unroll
                for (int n = 0; n < 2; ++n) g[bj][n] = *(const f32x4*)(gn + 32 * bj + 8 * fq + 4 * n);
            bf16_t* dst = (bf16_t*)(R + (isq ? R_Q : (isctx ? R_KC : R_K)));
#pragma unroll
            for (int ai = 0; ai < 2; ++ai)
#pragma unroll
                for (int m = 0; m < 4; ++m) {
                    float ss = 0.f;
#pragma unroll
                    for (int bj = 0; bj < 2; ++bj)
#pragma unroll
                        for (int n = 0; n < 2; ++n) { const f32x4 v = acc[ai][bj][m][n]; ss += v[0] * v[0] + v[1] * v[1] + v[2] * v[2] + v[3] * v[3]; }
                    ss += __shfl_xor(ss, 16); ss += __shfl_xor(ss, 32);
                    const float rs = rsqrtf(ss * (ISC * ISC / 64.0f) + 1e-6f) * osc * ISC;
                    const int row = rowbase + 128 * ai + 64 * wr + 16 * m + fr;
#pragma unroll
                    for (int bj = 0; bj < 2; ++bj) {
                        const f32x4 v0 = acc[ai][bj][m][0] * rs * g[bj][0], v1 = acc[ai][bj][m][1] * rs * g[bj][1];
                        u32x4 w; w.x = pk_bf16(v0[0], v0[1]); w.y = pk_bf16(v0[2], v0[3]); w.z = pk_bf16(v1[0], v1[1]); w.w = pk_bf16(v1[2], v1[3]);
                        *(u32x4*)(dst + (size_t)row * 512 + head * 64 + 32 * bj + 8 * fq) = w;
                    }
                }
        } else {
            const bool gel = pn >= 8; const int colbase = 256 * ((pn - 6) & 1) + 64 * wc;
            bf16_t* dst = (bf16_t*)(R + (gel ? R_GB : (isctx ? R_XBC : R_XB)));
#pragma unroll
            for (int ai = 0; ai < 2; ++ai)
#pragma unroll
                for (int m = 0; m < 4; ++m) {
                    const int row = rowbase + 128 * ai + 64 * wr + 16 * m + fr;
#pragma unroll
                    for (int bj = 0; bj < 2; ++bj) {
                        f32x4 v0 = acc[ai][bj][m][0], v1 = acc[ai][bj][m][1];
                        if (gel) {
#pragma unroll
                            for (int q = 0; q < 4; ++q) { v0[q] = gelu_tanh(v0[q]); v1[q] = gelu_tanh(v1[q]); }
                        }
                        u32x4 w; w.x = pk_bf16(v0[0], v0[1]); w.y = pk_bf16(v0[2], v0[3]); w.z = pk_bf16(v1[0], v1[1]); w.w = pk_bf16(v1[2], v1[3]);
                        *(u32x4*)(dst + (size_t)row * 512 + colbase + 32 * bj + 8 * fq) = w;
                    }
                }
        } } else {
            const int head = 4 * (pn - 4) + wc;
            bf16_t* dst = (bf16_t*)(R + (isctx ? R_VCT : R_VT));
            const int tshift = isctx ? 8 : 12, tlen = isctx ? CTXL : SEQ;
#pragma unroll
            for (int ai = 0; ai < 2; ++ai)
#pragma unroll
                for (int m = 0; m < 4; ++m) {
                    const int tok = rowbase + 128 * ai + 64 * wr + 16 * m + 4 * fq;
                    const int b = tok >> tshift, nn = tok & (tlen - 1);
#pragma unroll
                    for (int bj = 0; bj < 2; ++bj)
#pragma unroll
                        for (int n = 0; n < 2; ++n) {
                            const int d = 32 * bj + 8 * (fr >> 2) + 4 * n + (fr & 3);
                            const f32x4 v = acc[ai][bj][m][n] * ISC;
                            u32x2 w; w.x = pk_bf16(v[0], v[1]); w.y = pk_bf16(v[2], v[3]);
                            *(u32x2*)(dst + ((size_t)((b * 8 + head) * 64 + d)) * tlen + nn) = w;
                        }
                }
        }
    }
};

template <int KK, bool BASE_BF16>
struct JobResid {
    static constexpr int K = KK, LDB = KK, KSPLIT = KK / 64, SWAPPED = 0, FP8 = 0; static constexpr int SYNC = 0;
    const bf16_t* A; const bf16_t* Bt; const void* base; bf16_t* out; const float* gate;
    DEV const char* bbase() const { return (const char*)Bt; }
    DEV bool get(int i, UCtx& c, const int (&Rr)[2], const int (&Cc)[2]) const {
        int pm, pn; if (!deal(i, 128, 4, pm, pn)) return false;
        c.A = (const char*)A; c.B0 = (const char*)Bt + (size_t)(256 * pn) * LDB * 2; c.B1 = c.B0;
#pragma unroll
        for (int h = 0; h < 2; ++h)
#pragma unroll
            for (int k = 0; k < 2; ++k) c.aoff[h][k] = (unsigned)((256 * pm + 128 * h + Rr[k]) * K + Cc[k]) * 2u;
        c.i0 = pm; c.i1 = pn; c.i2 = 0; c.i3 = 0; c.i4 = 0; c.swap = 0; return true;
    }
    DEV void epi(const f32x4 (&acc)[2][2][4][2], const UCtx& c, int wr, int wc, int fr, int fq) const {
        const int pm = c.i0, pn = c.i1; const int b = pm >> 4;
        const int col0 = 256 * pn + 32 * wc + 8 * fq;
        f32x4 gv[2][2];
#pragma unroll
        for (int bj = 0; bj < 2; ++bj)
#pragma unroll
            for (int n = 0; n < 2; ++n) gv[bj][n] = *(const f32x4*)(gate + (size_t)b * 6144 + col0 + 128 * bj + 4 * n);
#pragma unroll
        for (int ai = 0; ai < 2; ++ai)
#pragma unroll
        for (int mp = 0; mp < 2; ++mp) {
            f32x4 bs[2][2][2];
#pragma unroll
            for (int mm = 0; mm < 2; ++mm) { const size_t off = (size_t)(256 * pm + 128 * ai + 64 * wr + 16 * (2 * mp + mm) + fr) * DM + col0;
#pragma unroll
                for (int bj = 0; bj < 2; ++bj) {
                    if constexpr (BASE_BF16) { const u32x4 w = *(const u32x4*)((const bf16_t*)base + off + 128 * bj); bs[mm][bj][0] = (f32x4){bflo(w.x), bfhi(w.x), bflo(w.y), bfhi(w.y)}; bs[mm][bj][1] = (f32x4){bflo(w.z), bfhi(w.z), bflo(w.w), bfhi(w.w)}; }
                    else { bs[mm][bj][0] = *(const f32x4*)((const float*)base + off + 128 * bj); bs[mm][bj][1] = *(const f32x4*)((const float*)base + off + 128 * bj + 4); } } }
#pragma unroll
            for (int mm = 0; mm < 2; ++mm) { const int m = 2 * mp + mm; const size_t off = (size_t)(256 * pm + 128 * ai + 64 * wr + 16 * m + fr) * DM + col0;
#pragma unroll
                for (int bj = 0; bj < 2; ++bj) { const f32x4 v0 = bs[mm][bj][0] + gv[bj][0] * acc[ai][bj][m][0], v1 = bs[mm][bj][1] + gv[bj][1] * acc[ai][bj][m][1];
                    u32x4 w; w.x = pk_bf16(v0[0], v0[1]); w.y = pk_bf16(v0[2], v0[3]); w.z = pk_bf16(v1[0], v1[1]); w.w = pk_bf16(v1[2], v1[3]); *(u32x4*)(out + off + 128 * bj) = w; } }
        }
    }
};

template <int PART>
struct JobHerm {
    static constexpr int K = 1024, LDB = 2048, KSPLIT = 8, SWAPPED = 0, FP8 = 1; static constexpr int SYNC = 0;
    P p; bf16_t* xa;
    DEV const char* bbase() const { return (const char*)(p.ws + WS_WFOLD); }
    DEV bool get(int i, UCtx& c, const int (&Rr)[2], const int (&Cc)[2]) const {
        int pm, pn; if (!deal(i, 64, 4, pm, pn)) return false;
        c.A = (const char*)(p.ws + WS_R + R_Y) + PART * 1024; c.B0 = (const char*)(p.ws + WS_WFOLD) + ((size_t)(256 * pn) * LDB + PART * 1024); c.B1 = c.B0;
#pragma unroll
        for (int h = 0; h < 2; ++h)
#pragma unroll
            for (int k = 0; k < 2; ++k) c.aoff[h][k] = (unsigned)((256 * pm + 128 * h + Rr[k]) * 2048 + Cc[k] * 2);
        c.i0 = pm; c.i1 = pn; c.i2 = 0; c.i3 = 0; c.i4 = 0; c.swap = 0; return true;
    }
    DEV void epi(const f32x4 (&acc)[2][2][4][2], const UCtx& c, int wr, int wc, int fr, int fq) const {
        constexpr float ISC = 1.0f / (F8_SY * F8_SWF);
        const int pm = c.i0, pn = c.i1; const int b = pm >> 3;
        const int col0 = 256 * pn + 32 * wc + 8 * fq;
        bf16_t* Pb = (bf16_t*)(p.ws + WS_R + R_P);
        if constexpr (PART == 0) {
#pragma unroll
            for (int ai = 0; ai < 2; ++ai)
#pragma unroll
                for (int m = 0; m < 4; ++m) { const size_t off = (size_t)(256 * pm + 128 * ai + 64 * wr + 16 * m + fr) * DM + col0;
#pragma unroll
                    for (int bj = 0; bj < 2; ++bj) { const f32x4 v0 = acc[ai][bj][m][0] * ISC, v1 = acc[ai][bj][m][1] * ISC;
                        u32x4 w; w.x = pk_bf16(v0[0], v0[1]); w.y = pk_bf16(v0[2], v0[3]); w.z = pk_bf16(v1[0], v1[1]); w.w = pk_bf16(v1[2], v1[3]); *(u32x4*)(Pb + off + 128 * bj) = w; } }
        } else {
            const float* gate = (const float*)(p.ws + WS_MOD) + (size_t)9 * 6144 + 2048 + (size_t)b * 6144 + col0;
            f32x4 gv[2][2];
#pragma unroll
            for (int bj = 0; bj < 2; ++bj)
#pragma unroll
                for (int n = 0; n < 2; ++n) gv[bj][n] = *(const f32x4*)(gate + 128 * bj + 4 * n);
#pragma unroll
            for (int ai = 0; ai < 2; ++ai)
#pragma unroll
                for (int m = 0; m < 4; ++m) {
                    const int prow = 256 * pm + 128 * ai + 64 * wr + 16 * m + fr, kk = prow & 2047;
                    const size_t poff = (size_t)prow * DM + col0;
                    const size_t o1 = ((size_t)b * SEQ + kk) * DM + col0, o2 = ((size_t)b * SEQ + ((SEQ - kk) & (SEQ - 1))) * DM + col0;
                    u32x4 pw[2], x1[2], x2[2];
#pragma unroll
                    for (int bj = 0; bj < 2; ++bj) { pw[bj] = *(const u32x4*)(Pb + poff + 128 * bj); x1[bj] = *(const u32x4*)(xa + o1 + 128 * bj); x2[bj] = *(const u32x4*)(xa + o2 + 128 * bj); }
#pragma unroll
                    for (int bj = 0; bj < 2; ++bj) {
                        const unsigned pwv[4] = {pw[bj].x, pw[bj].y, pw[bj].z, pw[bj].w}, x1v[4] = {x1[bj].x, x1[bj].y, x1[bj].z, x1[bj].w}, x2v[4] = {x2[bj].x, x2[bj].y, x2[bj].z, x2[bj].w};
                        unsigned r1[4], r2[4];
#pragma unroll
                        for (int q = 0; q < 4; ++q) {
                            const float g0 = gv[bj][q >> 1][2 * (q & 1)], g1 = gv[bj][q >> 1][2 * (q & 1) + 1];
                            const float q0 = acc[ai][bj][m][q >> 1][2 * (q & 1)] * ISC, q1 = acc[ai][bj][m][q >> 1][2 * (q & 1) + 1] * ISC;
                            const float p0 = bflo(pwv[q]), p1 = bfhi(pwv[q]);
                            r1[q] = pk_bf16(bflo(x1v[q]) + g0 * (p0 + q0), bfhi(x1v[q]) + g1 * (p1 + q1));
                            r2[q] = pk_bf16(bflo(x2v[q]) + g0 * (p0 - q0), bfhi(x2v[q]) + g1 * (p1 - q1));
                        }
                        *(u32x4*)(xa + o1 + 128 * bj) = (u32x4){r1[0], r1[1], r1[2], r1[3]};
                        if (kk != 0) *(u32x4*)(xa + o2 + 128 * bj) = (u32x4){r2[0], r2[1], r2[2], r2[3]};
                    }
                }
        }
    }
};
DEV void phase_herm_row2048(const P& p, LAS unsigned char* lds, bf16_t* xa) {
    const int tid = tid_(), bid = (int)blockIdx.x;
    if (bid >= 64) return;
    const int b = bid >> 3, o = 128 * (bid & 7) + (tid & 127), kq = tid >> 7;
    const float* y = (const float*)(p.ws + WS_Y2048) + b * 1024 + 256 * kq;
    const unsigned char* w = p.ws + WS_WFOLD + (size_t)l8row(o) * 2048 + 256 * kq;
    float a = 0.f;
#pragma unroll 4
    for (int k = 0; k < 256; k += 8) { const u32x2 ww = *(const u32x2*)(w + k); const f32x4 y0 = *(const f32x4*)(y + k), y1 = *(const f32x4*)(y + k + 4);
        const f32v2_ w01 = __builtin_amdgcn_cvt_pk_f32_fp8((int)ww.x, false), w23 = __builtin_amdgcn_cvt_pk_f32_fp8((int)ww.x, true), w45 = __builtin_amdgcn_cvt_pk_f32_fp8((int)ww.y, false), w67 = __builtin_amdgcn_cvt_pk_f32_fp8((int)ww.y, true);
        a += y0[0] * w01[0] + y0[1] * w01[1] + y0[2] * w23[0] + y0[3] * w23[1] + y1[0] * w45[0] + y1[1] * w45[1] + y1[2] * w67[0] + y1[3] * w67[1]; }
    a *= (1.0f / F8_SWF);
    LAS float* red = (LAS float*)lds;
    red[tid] = a; __syncthreads();
    if (tid < 128) { const float tot = (red[tid] + red[tid + 128]) + (red[tid + 256] + red[tid + 384]);
        const float g = ((const float*)(p.ws + WS_MOD))[(size_t)9 * 6144 + (size_t)b * 6144 + 2048 + o];
        bf16_t* x = xa + ((size_t)b * SEQ + 2048) * DM + o; *x = f2bf(bf2f(*x) + g * tot); }
    __syncthreads();
}

struct JobFold {
    static constexpr int K = 256, LDB = 256, KSPLIT = 4, SWAPPED = 0, FP8 = 0; static constexpr int SYNC = 0;
    P p;
    DEV const char* bbase() const { return (const char*)(p.ws + WS_CS); }
    DEV bool get(int i, UCtx& c, const int (&Rr)[2], const int (&Cc)[2]) const {
        const int u = (int)blockIdx.x; if (i != 0 || u >= 32) return false;
        const int g = u >> 3, pm = (u >> 1) & 3, pn = u & 1;
        c.A = (const char*)(p.ws + WS_WF); c.B0 = (const char*)(p.ws + WS_CS) + (size_t)(256 * pn) * LDB * 2; c.B1 = c.B0;
#pragma unroll
        for (int h = 0; h < 2; ++h)
#pragma unroll
            for (int k = 0; k < 2; ++k) c.aoff[h][k] = (unsigned)((256 * pm + 128 * h + Rr[k]) * 1024 + g * 256 + Cc[k]) * 2u;
        c.i0 = pm; c.i1 = pn; c.i2 = g; c.i3 = 0; c.i4 = 0; c.swap = 0; return true;
    }
    DEV void epi(const f32x4 (&acc)[2][2][4][2], const UCtx& c, int wr, int wc, int fr, int fq) const {
        unsigned char* W = p.ws + WS_WFOLD;
        const int pm = c.i0, pn = c.i1, g = c.i2;
#pragma unroll
        for (int ai = 0; ai < 2; ++ai)
#pragma unroll
            for (int m = 0; m < 4; ++m) {
                const int o = l8row(256 * pm + 128 * ai + 64 * wr + 16 * m + fr);
#pragma unroll
                for (int bj = 0; bj < 2; ++bj)
#pragma unroll
                    for (int n = 0; n < 2; ++n) {
                        const f32x4 v = acc[ai][bj][m][n] * (F8_SWF / 1024.0f);
                        *(unsigned*)(W + (size_t)o * 2048 + pn * 1024 + g * 256 + 128 * bj + 32 * wc + 16 * n + 4 * fq) = pk4_fp8(v[0], v[1], v[2], v[3]);
                    }
            }
    }
};

struct MoeTab { int tstart[NPAIR + 1]; int sbase[NPAIR + 1]; int cnt[NPAIR]; };
DEV void moe_build_tab(const unsigned* cntg, LAS MoeTab* tab) {
    if (threadIdx.x == 0) {
        int ts = 0, sb = 0;
        for (int q = 0; q < NPAIR; ++q) { int n = (int)cntg[q * 32]; if (n > LISTCAP) n = LISTCAP; tab->cnt[q] = n; tab->tstart[q] = ts; tab->sbase[q] = sb; const int nt = (n + 255) >> 8; ts += nt; sb += nt << 8; }
        tab->tstart[NPAIR] = ts; tab->sbase[NPAIR] = sb;
    }
    __syncthreads();
}
DEV void pair_decode(int q, int& g, int& lo, int& hi) { g = q / 6; const int r = q - 6 * g; lo = r < 3 ? 0 : (r < 5 ? 1 : 2); hi = r < 3 ? r + 1 : (r < 5 ? r - 1 : 3); }

struct JobGateUp {
    static constexpr int K = 1024, LDB = 1024, KSPLIT = 8, SWAPPED = 0, FP8 = 1, SYNC = 1;
    P p; int layer; const LAS MoeTab* tab;
    DEV const char* bbase() const { return (const char*)(p.ws + WS_WGU); }
    DEV bool get(int i, UCtx& c, const int (&Rr)[2], const int (&Cc)[2]) const {
        int ti, pn; if (!deal(i, tab->tstart[NPAIR], 8, ti, pn)) return false;
        int q = 0; while (q < NPAIR - 1 && ti >= tab->tstart[q + 1]) ++q;
        const int tin = ti - tab->tstart[q], l0 = tin << 8, np = tab->cnt[q], slot0 = tab->sbase[q] + l0;
        int g, lo, hi; pair_decode(q, g, lo, hi);
        const int e = 4 * g + (pn < 4 ? lo : hi);
        const unsigned* list = (const unsigned*)(p.ws + WS_LIST) + (size_t)q * LISTCAP;
        c.A = (const char*)(p.ws + WS_H);
        c.B0 = (const char*)(p.ws + WS_WGU) + ((size_t)(layer * 16 + e) * 1024 + 256 * (pn & 3)) * LDB; c.B1 = c.B0;
#pragma unroll
        for (int h = 0; h < 2; ++h)
#pragma unroll
            for (int k = 0; k < 2; ++k) { int pos = l0 + 128 * h + Rr[k]; if (pos >= np) pos = 0; const unsigned tok = list[pos]; c.aoff[h][k] = tok * 1024u + (unsigned)Cc[k] * 2u; }
        c.i0 = q; c.i1 = pn; c.i2 = l0; c.i3 = np; c.i4 = slot0; c.swap = 0; return true;
    }
    DEV unsigned* tile_counter(const UCtx& c) const { return (unsigned*)(p.ws + WS_CNT + 13 * KB_) + layer * 256 + tab->tstart[c.i0] + (c.i2 >> 8); }
    DEV void epi(const f32x4 (&acc)[2][2][4][2], const UCtx& c, int wr, int wc, int fr, int fq) const {
        const int q = c.i0, pn = c.i1, l0 = c.i2, np = c.i3, slot0 = c.i4;
        const float2* sw = (const float2*)(p.ws + WS_SLOTW) + (size_t)q * LISTCAP;
        unsigned char* hid = p.ws + WS_R + R_HID;
        constexpr float ISC = 1.0f / (F8_SH * F8_SW);
#pragma unroll
        for (int ai = 0; ai < 2; ++ai)
#pragma unroll
            for (int m = 0; m < 4; ++m) {
                const int r = 128 * ai + 64 * wr + 16 * m + fr; int pos = l0 + r; if (pos >= np) pos = np - 1;
                const float2 w2 = sw[pos]; const float w = (pn < 4 ? w2.x : w2.y) * (F8_SHID * ISC * ISC);
                float o[8];
#pragma unroll
                for (int n = 0; n < 2; ++n)
#pragma unroll
                    for (int k = 0; k < 4; ++k) { const float ga = acc[ai][0][m][n][k], up = acc[ai][1][m][n][k];
                        o[4 * n + k] = (w * ga) * up * __builtin_amdgcn_rcpf(1.0f + __builtin_amdgcn_exp2f(ga * (-LOG2E * ISC))); }
                u32x2 pk; pk.x = pk4_fp8(o[0], o[1], o[2], o[3]); pk.y = pk4_fp8(o[4], o[5], o[6], o[7]);
                __hip_atomic_store((unsigned long long*)(hid + (size_t)(slot0 + r) * 1024 + 128 * pn + 32 * wc + 8 * fq), ((unsigned long long)pk.y << 32) | pk.x, __ATOMIC_RELAXED, __HIP_MEMORY_SCOPE_AGENT);
            }
    }
};

template <bool OUT_F32>
struct JobDown {
    static constexpr int K = 1024, LDB = 512, KSPLIT = 4, SWAPPED = 0, FP8 = 1, SYNC = 2;
    P p; int layer; const LAS MoeTab* tab; void* outp;
    DEV const char* bbase() const { return (const char*)(p.ws + WS_WD); }
    DEV bool get(int i, UCtx& c, const int (&Rr)[2], const int (&Cc)[2]) const {
        int ti, pn; if (!deal(i, tab->tstart[NPAIR], 4, ti, pn, true)) return false;
        int q = 0; while (q < NPAIR - 1 && ti >= tab->tstart[q + 1]) ++q;
        const int tin = ti - tab->tstart[q], l0 = tin << 8, np = tab->cnt[q], slot0 = tab->sbase[q] + l0;
        int g, lo, hi; pair_decode(q, g, lo, hi);
        c.A = (const char*)(p.ws + WS_R + R_HID);
        c.B0 = (const char*)(p.ws + WS_WD) + ((size_t)(layer * 16 + 4 * g + lo) * 1024 + 256 * pn) * LDB;
        c.B1 = (const char*)(p.ws + WS_WD) + ((size_t)(layer * 16 + 4 * g + hi) * 1024 + 256 * pn) * LDB;
#pragma unroll
        for (int h = 0; h < 2; ++h)
#pragma unroll
            for (int k = 0; k < 2; ++k) c.aoff[h][k] = (unsigned)((slot0 + 128 * h + Rr[k]) * 1024 + Cc[k] * 2);
        c.i0 = q; c.i1 = pn; c.i2 = l0; c.i3 = np; c.i4 = 0; c.swap = 0; return true;
    }
    DEV unsigned* tile_counter(const UCtx& c) const { return (unsigned*)(p.ws + WS_CNT + 13 * KB_) + layer * 256 + tab->tstart[c.i0] + (c.i2 >> 8); }
    DEV void epi(const f32x4 (&acc)[2][2][4][2], const UCtx& c, int wr, int wc, int fr, int fq) const {
        const int q = c.i0, pn = c.i1, l0 = c.i2, np = c.i3;
        const unsigned* list = (const unsigned*)(p.ws + WS_LIST) + (size_t)q * LISTCAP;
        const float* gate = (const float*)(p.ws + WS_MOD) + (size_t)layer * 9 * 6144 + 5 * 1024;
        const int col0 = 256 * pn + 32 * wc + 8 * fq;
        unsigned tok[2][4];
#pragma unroll
        for (int ai = 0; ai < 2; ++ai)
#pragma unroll
            for (int m = 0; m < 4; ++m) { const int pos = l0 + 128 * ai + 64 * wr + 16 * m + fr; tok[ai][m] = list[pos < np ? pos : 0]; }
#pragma unroll
        for (int ai = 0; ai < 2; ++ai)
#pragma unroll
        for (int mp = 0; mp < 2; ++mp) {
            u32x4 bw[2][2];
#pragma unroll
            for (int mm = 0; mm < 2; ++mm) { const bf16_t* brow = (const bf16_t*)(p.ws + WS_XA) + (size_t)tok[ai][2 * mp + mm] * DM + col0;
#pragma unroll
                for (int bj = 0; bj < 2; ++bj) bw[mm][bj] = *(const u32x4*)(brow + 128 * bj); }
#pragma unroll
            for (int mm = 0; mm < 2; ++mm) {
                const int m = 2 * mp + mm;
                const int pos = l0 + 128 * ai + 64 * wr + 16 * m + fr;
                const int b = (int)(tok[ai][m] >> 12);
                const size_t ooff = (size_t)tok[ai][m] * DM + col0; const float* grow = gate + (size_t)b * 6144 + col0;
                float ssq = 0.f;
                if (pos < np) {
#pragma unroll
                    for (int bj = 0; bj < 2; ++bj) {
                        const f32x4 g0 = *(const f32x4*)(grow + 128 * bj), g1 = *(const f32x4*)(grow + 128 * bj + 4);
                        const u32x4 w = bw[mm][bj];
                        constexpr float ISC = 1.0f / (F8_SHID * F8_SW);
                        const f32x4 v0 = (f32x4){bflo(w.x), bfhi(w.x), bflo(w.y), bfhi(w.y)} + g0 * (acc[ai][bj][m][0] * ISC), v1 = (f32x4){bflo(w.z), bfhi(w.z), bflo(w.w), bfhi(w.w)} + g1 * (acc[ai][bj][m][1] * ISC);
                        if constexpr (OUT_F32) { *(f32x4*)((float*)outp + ooff + 128 * bj) = v0; *(f32x4*)((float*)outp + ooff + 128 * bj + 4) = v1; }
                        else { u32x4 o; o.x = pk_bf16(v0[0], v0[1]); o.y = pk_bf16(v0[2], v0[3]); o.z = pk_bf16(v1[0], v1[1]); o.w = pk_bf16(v1[2], v1[3]); *(u32x4*)((bf16_t*)outp + ooff + 128 * bj) = o;
                            ssq += bflo(o.x) * bflo(o.x) + bfhi(o.x) * bfhi(o.x) + bflo(o.y) * bflo(o.y) + bfhi(o.y) * bfhi(o.y) + bflo(o.z) * bflo(o.z) + bfhi(o.z) * bfhi(o.z) + bflo(o.w) * bflo(o.w) + bfhi(o.w) * bfhi(o.w); }
                    }
                }
                if constexpr (!OUT_F32) {
                    ssq += __shfl_xor(ssq, 16); ssq += __shfl_xor(ssq, 32);
                    if (pos < np && fq == 0) ((float*)(p.ws + WS_PART))[(size_t)tok[ai][m] * 16 + 4 * pn + wc] = ssq;
                }
            }
        }
    }
};

DEV int maprow(int map, int c) {
    if (map == 0) return c;
    if (map == 4) return l8row(c);
    if (map == 1) { const int t = c >> 8, wc = (c >> 6) & 3, bj = (c >> 5) & 1, fq = (c >> 3) & 3, n = (c >> 2) & 1, i = c & 3; return (t << 8) + bj * 128 + wc * 32 + n * 16 + fq * 4 + i; }
    const int t = c >> 7, wc = (c >> 5) & 3, fq = (c >> 3) & 3, n = (c >> 2) & 1, i = c & 3; return (t << 8) + (map == 3 ? 128 : 0) + wc * 32 + n * 16 + fq * 4 + i;
}
struct TT { const float* src; int ld; bf16_t* dst; int dstK; int map; int k0, c0; int f8; };
constexpr int NTT = 320 + 128 + 128 + 2048 * 3;
DEV void tt_decode(const P& p, int t, TT& o) {
    if (t < 320) { const int kb = t / 20, cb = t - 20 * kb; o.f8 = cb < 12 ? 1 : 0; o.src = p.mix_w_in; o.ld = 2560; o.dst = cb < 12 ? (bf16_t*)(p.ws + WS_WIN) : (bf16_t*)(p.ws + WS_WIN + 2 * MB_) - (size_t)1536 * 1024; o.dstK = 1024; o.map = 1; o.k0 = 64 * kb; o.c0 = 128 * cb; return; }
    t -= 320;
    if (t < 256) { const bool f = t >= 128; const int tt = t & 127, kb = tt >> 3, cb = tt & 7; o.f8 = 0; o.src = f ? p.fnet_w : p.mix_w_out; o.ld = 1024; o.dst = (bf16_t*)(p.ws + (f ? WS_WF : WS_WOUT)); o.dstK = 1024; o.map = f ? 0 : 4; o.k0 = 64 * kb; o.c0 = 128 * cb; return; }
    t -= 256;
    if (t < 4096) { const bool up = t >= 2048; const int tt = t & 2047, le = tt >> 6, r = tt & 63, kb = r >> 2, cb = r & 3;
        o.f8 = 1; o.src = (up ? p.wu : p.wg) + (size_t)le * 1024 * 512; o.ld = 512; o.dst = (bf16_t*)(p.ws + WS_WGU + (size_t)le * 1024 * 1024); o.dstK = 1024; o.map = up ? 3 : 2; o.k0 = 64 * kb; o.c0 = 128 * cb; return; }
    t -= 4096;
    { const int le = t >> 6, r = t & 63, kb = r >> 3, cb = r & 7; o.f8 = 1; o.src = p.wd + (size_t)le * 512 * 1024; o.ld = 1024; o.dst = (bf16_t*)(p.ws + WS_WD + (size_t)le * 1024 * 512); o.dstK = 512; o.map = 4; o.k0 = 64 * kb; o.c0 = 128 * cb; }
}
DEV void tt_load(const TT& t, f32x4 (&v)[4]) {
    const int tid = tid_(), rg = tid >> 5, c4 = tid & 31;
#pragma unroll
    for (int i = 0; i < 4; ++i) v[i] = *(const f32x4*)(t.src + (size_t)(t.k0 + (t.f8 ? 4 * rg + i : rg + 16 * i)) * t.ld + t.c0 + 4 * c4);
}
constexpr int TT_RS = 132;
constexpr int TT_RS8 = 80;
DEV void phase_prologue(const P& p, LAS unsigned char* lds) {
    const int tid = tid_(), G = (int)gridDim.x, bid = (int)blockIdx.x;
    unsigned char* ws = p.ws;
    for (int gt = bid * NTHREADS + tid; gt < 131072; gt += G * NTHREADS) {
        { const int row = gt >> 8, l = gt & 255, cc = row & 255; const int ph = (cc * l) & 255; const float ang = (float)ph * (6.283185307179586f / 256.0f);
          ((bf16_t*)(ws + WS_CS))[gt] = f2bf(row < 256 ? cosf(ang) : sinf(ang)); }
        { const int in = gt & 63, out = (gt >> 6) & 63, blk = (gt >> 12) & 7, gate = (gt >> 15) & 1, dir = (gt >> 16) & 1; const float* src = gate ? p.gi_w : p.gr_w;
          ((bf16_t*)(ws + WS_WGT))[gt] = f2bf(src[((dir * 8 + blk) * 64 + in) * 64 + out]); }
        if (gt < 8192) { const int row = gt >> 6, n1 = gt & 63, k1 = row & 63; const int ph = (k1 * n1) & 63; const float ang = (float)ph * (6.283185307179586f / 64.0f);
            ((bf16_t*)(ws + WS_F1))[gt] = f2bf(row < 64 ? cosf(ang) : -sinf(ang)); }
        if (gt < 16384) { const int half = gt >> 13, k2 = (gt >> 7) & 63, kk = gt & 127, n2 = kk & 63; const int ph = (k2 * n2) & 63; const float ang = (float)ph * (6.283185307179586f / 64.0f);
            const float cs = cosf(ang), sn = sinf(ang); const float v = half == 0 ? (kk < 64 ? cs : sn) : (kk < 64 ? -sn : cs);
            ((bf16_t*)(ws + WS_F2))[gt] = f2bf(v); }
        if (gt < 4096) { const int n2 = gt >> 6, k1 = gt & 63; const float ang = (float)(n2 * k1) * (6.283185307179586f / 4096.0f); ((float2*)(ws + WS_TW))[gt] = make_float2(cosf(ang), sinf(ang)); }
        if (gt < 3720) ((float*)(ws + WS_RPB2))[gt] = p.rpb[gt] * LOG2E;
        if (gt < 1024) { const float lm = p.lam[gt]; ((float*)(ws + WS_LA8))[gt] = -8.0f * log1pf(expf(-lm)); }
    }
    {
        LAS float* sc = (LAS float*)lds;
        LAS float* red = (LAS float*)(lds + 49152);
        for (int idx = tid; idx < 9 * 1024; idx += NTHREADS) { const int b = idx >> 10, k = idx & 1023; const float v = b < 8 ? p.c[b * 1024 + k] : p.c_ctx[k]; sc[k * 12 + b] = v / (1.0f + __expf(-v)); }
        __syncthreads();
        for (int task = bid; task < 768; task += G) {
            const int l = task / 384, r = task - 384 * l, chunk = r >> 2, kq = r & 3;
            const int col = tid & 63, ks = tid >> 6, n = chunk * 64 + col;
            float a[9];
#pragma unroll
            for (int b = 0; b < 9; ++b) a[b] = 0.f;
            const float* w = p.ada_w + (size_t)l * 1024 * 6144 + n; const int k0 = kq * 256 + ks * 32;
#pragma unroll 8
            for (int kk = 0; kk < 32; ++kk) { const int k = k0 + kk; const float wv = w[(size_t)k * 6144];
                const f32x4 s0 = *(const LAS f32x4*)(sc + k * 12), s1 = *(const LAS f32x4*)(sc + k * 12 + 4), s2 = *(const LAS f32x4*)(sc + k * 12 + 8);
                a[0] += wv * s0[0]; a[1] += wv * s0[1]; a[2] += wv * s0[2]; a[3] += wv * s0[3]; a[4] += wv * s1[0]; a[5] += wv * s1[1]; a[6] += wv * s1[2]; a[7] += wv * s1[3]; a[8] += wv * s2[0]; }
#pragma unroll
            for (int b = 0; b < 9; ++b) red[(ks * 64 + col) * 9 + b] = a[b];
            __syncthreads();
            if (tid < 64) {
#pragma unroll
                for (int b = 0; b < 9; ++b) { float s2 = 0.f;
#pragma unroll
                    for (int q = 0; q < 8; ++q) s2 += red[(q * 64 + tid) * 9 + b];
                    ((float*)(ws + WS_MODP))[((size_t)(kq * 2 + l) * 9 + b) * 6144 + n] = s2; }
            }
            __syncthreads();
        }
    }
    {
        LAS bf16_t* tile = (LAS bf16_t*)lds;
        int t = bid; TT cur, nx; f32x4 v[4], vn[4];
        if (t < NTT) { tt_decode(p, t, cur); tt_load(cur, v); }
        int par = 0;
        for (; t < NTT; t += G) {
            const bool hn = (t + G) < NTT;
            if (hn) { tt_decode(p, t + G, nx); tt_load(nx, vn); }
            LAS bf16_t* tl = tile + par * 64 * TT_RS;
            if (cur.f8) {
                LAS unsigned char* t8 = (LAS unsigned char*)tl;
                { const int rg = tid >> 5, c4 = tid & 31;
#pragma unroll
                  for (int j = 0; j < 4; ++j) *(LAS unsigned*)(t8 + (4 * c4 + j) * TT_RS8 + 4 * rg) = pk4_fp8(v[0][j] * F8_SW, v[1][j] * F8_SW, v[2][j] * F8_SW, v[3][j] * F8_SW); }
                __syncthreads();
                { const int cc = tid >> 2, seg = tid & 3;
                  *(u32x4*)((unsigned char*)cur.dst + (size_t)maprow(cur.map, cur.c0 + cc) * cur.dstK + cur.k0 + seg * 16) = *(const LAS u32x4*)(t8 + cc * TT_RS8 + seg * 16); }
            } else {
            { const int row = tid >> 5, c4 = tid & 31;
#pragma unroll
              for (int i = 0; i < 4; ++i) { u32x2 w; w.x = pk_bf16_asm(v[i][0], v[i][1]); w.y = pk_bf16_asm(v[i][2], v[i][3]); *(LAS u32x2*)(tl + (row + 16 * i) * TT_RS + 4 * c4) = w; } }
            __syncthreads();
#pragma unroll
            for (int j = 0; j < 2; ++j) { const int qd = tid + NTHREADS * j, cc = qd >> 3, seg = qd & 7;
                unsigned short e[8];
#pragma unroll
                for (int i = 0; i < 8; ++i) e[i] = tl[(seg * 8 + i) * TT_RS + cc];
                u32x4 w; w.x = e[0] | ((unsigned)e[1] << 16); w.y = e[2] | ((unsigned)e[3] << 16); w.z = e[4] | ((unsigned)e[5] << 16); w.w = e[6] | ((unsigned)e[7] << 16);
                *(u32x4*)(cur.dst + (size_t)maprow(cur.map, cur.c0 + cc) * cur.dstK + cur.k0 + seg * 8) = w; }
            }
            par ^= 1;
            if (hn) { cur = nx;
#pragma unroll
                for (int i = 0; i < 4; ++i) v[i] = vn[i]; }
        }
        __syncthreads();
    }
}

DEV f32x4 mod_parts4(const P& p, int l, int b, int e) {
    const float* mp = (const float*)(p.ws + WS_MODP) + ((size_t)l * 9 + b) * 6144 + e; constexpr size_t QS = (size_t)2 * 9 * 6144;
    const f32x4 a = *(const f32x4*)(mp), b1 = *(const f32x4*)(mp + QS), c = *(const f32x4*)(mp + 2 * QS), d = *(const f32x4*)(mp + 3 * QS), bs = *(const f32x4*)(p.ada_b + l * 6144 + e);
    return ((a + b1) + (c + d)) + bs;
}
DEV void phase_mod_final(const P& p) {
    const int tid = tid_();
    for (int i = (int)blockIdx.x * NTHREADS + tid; i < 2 * 9 * 6144 / 4; i += (int)gridDim.x * NTHREADS) {
        const int l = i / (9 * 1536), r = i - l * 9 * 1536, b = r / 1536, e = 4 * (r - b * 1536);
        *(f32x4*)((float*)(p.ws + WS_MOD) + ((size_t)l * 9 + b) * 6144 + e) = mod_parts4(p, l, b, e);
    }
}
template <bool PARTS, bool XBF, bool OUT8>
DEV void phase_norm_plain(const P& p, const void* xlat, int row_lo, int row_hi, int widx, int nwg, const float* gain, const float* modl  , int shift_off, int scale_off) {
    const int tid = tid_(), lane = tid & 63, wid = __builtin_amdgcn_readfirstlane(tid >> 6);
    const int gw = widx * 8 + wid, GW = nwg * 8;
    if (widx < 0) return;
    bf16_t* H = (bf16_t*)(p.ws + WS_H);
    const int nrows = row_hi - row_lo;
    const int per = (nrows + GW - 1) / GW;
    int bcur = -1; f32x4 gsc[4], sh[4];
    for (int row = row_lo + gw * per; row < row_lo + (gw + 1) * per && row < row_hi; ++row) {
        const int b = row < MTOK ? (row >> 12) : 8;
        if (b != bcur) { bcur = b; const float* mb = modl + (size_t)b * 6144;
#pragma unroll
            for (int j = 0; j < 4; ++j) { const int e = 4 * lane + 256 * j; const f32x4 g = *(const f32x4*)(gain + e); f32x4 sc;
                if constexpr (PARTS) { sc = mod_parts4(p, 0, b, scale_off + e); sh[j] = mod_parts4(p, 0, b, shift_off + e); }
                else { sc = *(const f32x4*)(mb + scale_off + e); sh[j] = *(const f32x4*)(mb + shift_off + e); }
                gsc[j] = g * (sc + 1.0f); } }
        const float* xr = row < MTOK ? (const float*)xlat + (size_t)row * DM : p.ctx + (size_t)(row - MTOK) * DM;
        f32x4 xv[4]; float ss = 0.f;
#pragma unroll
        for (int j = 0; j < 4; ++j) {
            if constexpr (XBF) { const u32x2 w = *(const u32x2*)((const bf16_t*)xlat + (size_t)row * DM + 4 * lane + 256 * j); xv[j] = (f32x4){bflo(w.x), bfhi(w.x), bflo(w.y), bfhi(w.y)}; }
            else xv[j] = *(const f32x4*)(xr + 4 * lane + 256 * j);
            ss += xv[j][0] * xv[j][0] + xv[j][1] * xv[j][1] + xv[j][2] * xv[j][2] + xv[j][3] * xv[j][3]; }
#pragma unroll
        for (int s2 = 32; s2 >= 1; s2 >>= 1) ss += __shfl_xor(ss, s2);
        const float rs = rsqrtf(ss * (1.0f / 1024.0f) + 1e-6f);
#pragma unroll
        for (int j = 0; j < 4; ++j) { const int e = 4 * lane + 256 * j;
            const f32x4 h = xv[j] * rs * gsc[j] + sh[j];
            u32x2 w; w.x = pk_bf16_asm(h[0], h[1]); w.y = pk_bf16_asm(h[2], h[3]);
            *(u32x2*)(H + (size_t)row * DM + e) = w;
            if constexpr (OUT8) *(unsigned*)((unsigned char*)p.out + (size_t)row * DM + e) = pk4_fp8(h[0] * F8_SH, h[1] * F8_SH, h[2] * F8_SH, h[3] * F8_SH); }
    }
}

DEV void phase_norm_router(const P& p, LAS unsigned char* lds, const bf16_t* xin, const float* gain, const float* modl, int layer) {
    const int tid = tid_(), lane = tid & 63, wid = __builtin_amdgcn_readfirstlane(tid >> 6);
    LAS u32x4* wh = (LAS u32x4*)lds;
    LAS u32x4* wlp = (LAS u32x4*)(lds + 32768);
    LAS float* gsl = (LAS float*)(lds + 65536 + 8192);
    LAS float* shl = (LAS float*)(lds + 65536 + 12288);
    LAS unsigned* lcnt = (LAS unsigned*)(lds + 65536);
    LAS unsigned* lbase = (LAS unsigned*)(lds + 65536 + 128);
    LAS u32x4* stash = (LAS u32x4*)(lds + 65536 + 256);
    if (tid < NPAIR) lcnt[tid] = 0u;
    bf16_t* H = (bf16_t*)(p.ws + WS_H);
    unsigned* cnt = (unsigned*)(p.ws + WS_CNT) + layer * 1024;
    unsigned* list = (unsigned*)(p.ws + WS_LIST); float2* slotw = (float2*)(p.ws + WS_SLOTW);
    const float rb = p.router_b[lane & 15];
    const int tkn = lane & 15, g = lane >> 4;
    int iter = 0;
    for (int chunk = (int)blockIdx.x; chunk < MTOK / 128; chunk += (int)gridDim.x) {
        const int b = chunk >> 5;
        const int tok0 = chunk * 128 + wid * 16;
        const bf16_t* xr = xin + (size_t)(tok0 + tkn) * DM + 8 * g;
        if (iter) __syncthreads();
        float rw[4][8], gm[2][3];
        if (iter == 0) {
#pragma unroll
            for (int i4 = 0; i4 < 4; ++i4) { const int idx = tid + NTHREADS * i4, l = idx & 63, ks = idx >> 6, e = l & 15, g2 = l >> 4;
#pragma unroll
                for (int q = 0; q < 8; ++q) rw[i4][q] = p.router_w[(32 * ks + 8 * g2 + q) * 16 + e]; }
        }
        { const float* mb = modl + (size_t)b * 6144;
#pragma unroll
          for (int kk = 0; kk < 2; ++kk) { const int k = tid + NTHREADS * kk; gm[kk][0] = gain[k]; gm[kk][1] = mb[4096 + k]; gm[kk][2] = mb[3072 + k]; } }
        u32x4 wv[32];
#pragma unroll
        for (int ks = 0; ks < 32; ++ks) wv[ks] = *(const u32x4*)(xr + 32 * ks);
        if (iter == 0) {
#pragma unroll
            for (int i4 = 0; i4 < 4; ++i4) { const int idx = tid + NTHREADS * i4; unsigned hi[4], lo[4];
#pragma unroll
                for (int q = 0; q < 4; ++q) { const float w0 = rw[i4][2 * q], w1 = rw[i4][2 * q + 1]; hi[q] = pk_bf16_asm(w0, w1); lo[q] = pk_bf16_asm(w0 - bflo(hi[q]), w1 - bfhi(hi[q])); }
                wh[idx] = (u32x4){hi[0], hi[1], hi[2], hi[3]}; wlp[idx] = (u32x4){lo[0], lo[1], lo[2], lo[3]}; }
        }
#pragma unroll
        for (int kk = 0; kk < 2; ++kk) { const int k = tid + NTHREADS * kk; gsl[k] = gm[kk][0] * (gm[kk][1] + 1.0f); shl[k] = gm[kk][2]; }
        __syncthreads();
        float ss = 0.f;
#pragma unroll
        for (int ks = 0; ks < 32; ++ks) { const u32x4 w = wv[ks]; const float a0 = bflo(w.x), a1 = bfhi(w.x), a2 = bflo(w.y), a3 = bfhi(w.y), a4 = bflo(w.z), a5 = bfhi(w.z), a6 = bflo(w.w), a7 = bfhi(w.w);
            ss += (a0 * a0 + a1 * a1) + (a2 * a2 + a3 * a3) + (a4 * a4 + a5 * a5) + (a6 * a6 + a7 * a7); }
        ss += __shfl_xor(ss, 16); ss += __shfl_xor(ss, 32);
        const float rs = rsqrtf(ss * (1.0f / 1024.0f) + 1e-6f);
        f32x4 lg = (f32x4){0.f, 0.f, 0.f, 0.f};
        unsigned char* hrow = (unsigned char*)H + (size_t)(tok0 + tkn) * DM + 8 * g;
#pragma unroll 8
        for (int ks = 0; ks < 32; ++ks) {
            const u32x4 w = *(const u32x4*)(xr + 32 * ks);
            const f32x4 g0 = *(const LAS f32x4*)(gsl + 32 * ks + 8 * g), g1 = *(const LAS f32x4*)(gsl + 32 * ks + 8 * g + 4), s0 = *(const LAS f32x4*)(shl + 32 * ks + 8 * g), s1 = *(const LAS f32x4*)(shl + 32 * ks + 8 * g + 4);
            const float h0 = bflo(w.x) * rs * g0[0] + s0[0], h1 = bfhi(w.x) * rs * g0[1] + s0[1], h2 = bflo(w.y) * rs * g0[2] + s0[2], h3 = bfhi(w.y) * rs * g0[3] + s0[3];
            const float h4 = bflo(w.z) * rs * g1[0] + s1[0], h5 = bfhi(w.z) * rs * g1[1] + s1[1], h6 = bflo(w.w) * rs * g1[2] + s1[2], h7 = bfhi(w.w) * rs * g1[3] + s1[3];
            u32x4 hh; hh.x = pk_bf16(h0, h1); hh.y = pk_bf16(h2, h3); hh.z = pk_bf16(h4, h5); hh.w = pk_bf16(h6, h7);
            { u32x2 h8; h8.x = pk4_fp8(h0 * F8_SH, h1 * F8_SH, h2 * F8_SH, h3 * F8_SH); h8.y = pk4_fp8(h4 * F8_SH, h5 * F8_SH, h6 * F8_SH, h7 * F8_SH); *(u32x2*)(hrow + 32 * ks) = h8; }
            u32x4 hl; hl.x = pk_bf16(h0 - bflo(hh.x), h1 - bfhi(hh.x)); hl.y = pk_bf16(h2 - bflo(hh.y), h3 - bfhi(hh.y)); hl.z = pk_bf16(h4 - bflo(hh.z), h5 - bfhi(hh.z)); hl.w = pk_bf16(h6 - bflo(hh.w), h7 - bfhi(hh.w));
            const bf16x8 ahi = __builtin_bit_cast(bf16x8, hh), alo = __builtin_bit_cast(bf16x8, hl);
            const bf16x8 bhi = __builtin_bit_cast(bf16x8, wh[ks * 64 + lane]), blo = __builtin_bit_cast(bf16x8, wlp[ks * 64 + lane]);
            lg = __builtin_amdgcn_mfma_f32_16x16x32_bf16(ahi, bhi, lg, 0, 0, 0);
            lg = __builtin_amdgcn_mfma_f32_16x16x32_bf16(ahi, blo, lg, 0, 0, 0);
            lg = __builtin_amdgcn_mfma_f32_16x16x32_bf16(alo, bhi, lg, 0, 0, 0);
        }
#pragma unroll
        for (int v = 0; v < 4; ++v) {
        const float logit = lg[v];
        const float score = 1.0f / (1.0f + expf(-logit)); const float sel = score + rb;
        const int qb = lane & ~3, tb = lane & ~15;
        const float s0 = __shfl(sel, qb), s1 = __shfl(sel, qb + 1), s2 = __shfl(sel, qb + 2), s3 = __shfl(sel, qb + 3);
        const float ma = fmaxf(s0, s1), mi = fminf(s0, s1), mc = fmaxf(s2, s3), md = fminf(s2, s3);
        const float gsum = fmaxf(ma, mc) + fmaxf(fminf(ma, mc), fmaxf(mi, md));
        const float g0 = __shfl(gsum, tb), g1 = __shfl(gsum, tb + 4), g2 = __shfl(gsum, tb + 8), g3 = __shfl(gsum, tb + 12);
        int best = 0; float bv = g0; if (g1 > bv) { bv = g1; best = 1; } if (g2 > bv) { bv = g2; best = 2; } if (g3 > bv) { bv = g3; best = 3; }
        const int eb = tb + 4 * best;
        float tv[4], cv[4];
#pragma unroll
        for (int q = 0; q < 4; ++q) { tv[q] = __shfl(sel, eb + q); cv[q] = __shfl(score, eb + q); }
        int ia = 0; float va = tv[0];
#pragma unroll
        for (int q = 1; q < 4; ++q) if (tv[q] > va) { va = tv[q]; ia = q; }
        int ib = -1; float vb = -3.0e38f;
#pragma unroll
        for (int q = 0; q < 4; ++q) if (q != ia && tv[q] > vb) { vb = tv[q]; ib = q; }
        float sa = 0.f, sb = 0.f;
#pragma unroll
        for (int q = 0; q < 4; ++q) { sa = (q == ia) ? cv[q] : sa; sb = (q == ib) ? cv[q] : sb; }
        const float inv = 1.0f / (sa + sb); const float wa = sa * inv, wb = sb * inv;
        const int lo = ia < ib ? ia : ib, hi = ia < ib ? ib : ia; const float wlo = ia < ib ? wa : wb, whi = ia < ib ? wb : wa;
        const int pidx = lo == 0 ? hi - 1 : (lo == 1 ? hi + 1 : 5);
        const int pair = best * 6 + pidx; const float wlo_ = wlo, whi_ = whi;
        if ((lane & 15) == 0) {
            const unsigned lpos = __hip_atomic_fetch_add(&lcnt[pair], 1u, __ATOMIC_RELAXED, __HIP_MEMORY_SCOPE_WORKGROUP);
            stash[(wid * 8 + iter * 4 + v) * 4 + (lane >> 4)] = (u32x4){(unsigned)pair, lpos, __float_as_uint(wlo_), __float_as_uint(whi_)};
        }
        }
        ++iter;
    }
    __syncthreads();
    if (tid < NPAIR) lbase[tid] = atomicAdd(&cnt[tid * 32], lcnt[tid]);
    __syncthreads();
    if (lane < 4) {
        int it2 = 0;
        for (int chunk = (int)blockIdx.x; chunk < MTOK / 128; chunk += (int)gridDim.x, ++it2) {
#pragma unroll
            for (int v = 0; v < 4; ++v) {
                const u32x4 sv = stash[(wid * 8 + it2 * 4 + v) * 4 + lane];
                const unsigned pair = sv.x, pos = lbase[pair] + sv.y;
                if (pos < (unsigned)LISTCAP) { list[(size_t)pair * LISTCAP + pos] = (unsigned)(chunk * 128 + wid * 16 + 4 * lane + v); slotw[(size_t)pair * LISTCAP + pos] = make_float2(__uint_as_float(sv.z), __uint_as_float(sv.w)); }
            }
        }
    }
    __syncthreads();
}

constexpr int AT_KC = 0, AT_KROW = 144;
constexpr int AT_VC = 256 * AT_KROW, AT_VROW = 528;
constexpr int AT_TB = AT_VC + 64 * AT_VROW;
constexpr int AT_IX = AT_TB + 2048;
DEV void phase_attention(const P& p, LAS unsigned char* lds) {
    const int tid = tid_(), lane = tid & 63, wid = __builtin_amdgcn_readfirstlane(tid >> 6);
    const unsigned char* R = p.ws + WS_R;
    const bf16_t* Q = (const bf16_t*)(R + R_Q); const bf16_t* Kb = (const bf16_t*)(R + R_K); const bf16_t* VT = (const bf16_t*)(R + R_VT);
    const bf16_t* KC = (const bf16_t*)(R + R_KC); const bf16_t* VCT = (const bf16_t*)(R + R_VCT);
    bf16_t* MIX = (bf16_t*)(p.ws + WS_R + R_MIX);
    const float* rpb2 = (const float*)(p.ws + WS_RPB2);
    if (tid < 64) {
#pragma unroll
        for (int cm = 0; cm < 6; ++cm) {
            const int c = cm / 3, cb = cm - 3 * c + c, qc = 16 * cb + (lane & 15), cs = clampi(qc - 8, 0, 48);
            unsigned w0 = 0u, w1 = 0u;
#pragma unroll
            for (int t = 0; t < 8; ++t) { const int kc = 32 * c + 8 * (lane >> 4) + t; const bool valid = kc >= cs && kc < cs + 16; const unsigned id = valid ? (unsigned)(clampi(kc - qc, -15, 15) + 15) : 31u;
                if (t < 4) w0 |= (id * 4u) << (8 * t); else w1 |= (id * 4u) << (8 * (t - 4)); }
            *(LAS u32x2*)(lds + AT_IX + (cm * 64 + lane) * 8) = (u32x2){w0, w1};
        }
    }
    const int nun = NB * 8 * 8, uper = (nun + (int)gridDim.x - 1) / (int)gridDim.x;
    int staged = -1;
    for (int u = (int)blockIdx.x * uper; u < ((int)blockIdx.x + 1) * uper && u < nun; ++u) {
        const int band = u & 7, h = (u >> 3) & 7, b = u >> 6;
        __syncthreads();
        int tl = tid; asm volatile("" : "+v"(tl));
        if ((u >> 3) != staged) { staged = u >> 3;
#pragma unroll
        for (int i = 0; i < 4; ++i) { const int cid = tl + NTHREADS * i;
            { const int key = cid >> 3, part = cid & 7; *(LAS u32x4*)(lds + AT_KC + key * AT_KROW + part * 16) = *(const u32x4*)(KC + (size_t)(b * CTXL + key) * 512 + h * 64 + part * 8); }
            { const int d = cid >> 5, part = cid & 31; *(LAS u32x4*)(lds + AT_VC + d * AT_VROW + part * 16) = *(const u32x4*)(VCT + (size_t)((b * 8 + h) * 64 + d) * CTXL + part * 8); } }
        if (tl < 480) { const int dr = tl >> 5, q = tl & 31; ((LAS float*)(lds + AT_TB))[tl] = q < 31 ? rpb2[h * 465 + dr * 31 + q] : -1.0e30f; }
        }
        __syncthreads();
        int ln = lane; asm volatile("" : "+v"(ln));
        const int j = ln & 15, g = ln >> 4, kap0 = 8 * (j >> 2) + (j & 3);
        const int r = 8 * band + wid;
        const int rs = clampi(r - 4, 0, 56);
        bf16x8 qf[4][2];
#pragma unroll
        for (int cb = 0; cb < 4; ++cb)
#pragma unroll
            for (int ks = 0; ks < 2; ++ks) qf[cb][ks] = *(const bf16x8*)(Q + (size_t)(b * SEQ + r * 64 + 16 * cb + j) * 512 + h * 64 + 32 * ks + 8 * g);
        f32x4 O[4][4]; float l[4];
#pragma unroll
        for (int cb = 0; cb < 4; ++cb) { l[cb] = 0.f;
#pragma unroll
            for (int db = 0; db < 4; ++db) O[cb][db] = (f32x4){0.f, 0.f, 0.f, 0.f}; }
        const bf16_t* vtb = VT + (size_t)((b * 8 + h) * 64 + j) * SEQ;
#define AT_LOADW(KF, VF, krow_, c_) do { const int ktok0_ = b * SEQ + (krow_) * 64 + 32 * (c_); \
            _Pragma("unroll") for (int blk = 0; blk < 2; ++blk) _Pragma("unroll") for (int ks = 0; ks < 2; ++ks) KF[blk][ks] = *(const bf16x8*)(Kb + (size_t)(ktok0_ + kap0 + 4 * blk) * 512 + h * 64 + 32 * ks + 8 * g); \
            _Pragma("unroll") for (int db = 0; db < 4; ++db) VF[db] = *(const bf16x8*)(vtb + (size_t)(16 * db) * SEQ + (krow_) * 64 + 32 * (c_) + 8 * g); } while (0)
#define AT_EVALW(KF, VF, c_) do { _Pragma("unroll") for (int q3 = 0; q3 < 3; ++q3) { const int cb = q3 + (c_), cm = 3 * (c_) + q3; f32x4 s_[2]; \
            _Pragma("unroll") for (int blk = 0; blk < 2; ++blk) { s_[blk] = __builtin_amdgcn_mfma_f32_16x16x32_bf16(KF[blk][0], qf[cb][0], (f32x4){0.f, 0.f, 0.f, 0.f}, 0, 0, 0); \
                s_[blk] = __builtin_amdgcn_mfma_f32_16x16x32_bf16(KF[blk][1], qf[cb][1], s_[blk], 0, 0, 0); } \
            float pv[8]; const u32x2 iw2 = *(const LAS u32x2*)(lds + AT_IX + (cm * 64 + ln) * 8); const unsigned iw[2] = {iw2.x, iw2.y}; \
            _Pragma("unroll") for (int t = 0; t < 8; ++t) { const unsigned off = (iw[t >> 2] >> (8 * (t & 3))) & 0xffu; const float bias = *(const LAS float*)(lds + tbrow + off); \
                pv[t] = __builtin_amdgcn_exp2f(s_[t >> 2][t & 3] + bias); l[cb] += pv[t]; } \
            u32x4 pw; pw.x = pk_bf16(pv[0], pv[1]); pw.y = pk_bf16(pv[2], pv[3]); pw.z = pk_bf16(pv[4], pv[5]); pw.w = pk_bf16(pv[6], pv[7]); \
            const bf16x8 pf = __builtin_bit_cast(bf16x8, pw); \
            _Pragma("unroll") for (int db = 0; db < 4; ++db) O[cb][db] = __builtin_amdgcn_mfma_f32_16x16x32_bf16(VF[db], pf, O[cb][db], 0, 0, 0); \
            if (q3 == 2) __builtin_amdgcn_sched_barrier(0); } } while (0)
#define AT_LOADC(KF, VF, c_) do { _Pragma("unroll") for (int blk = 0; blk < 2; ++blk) _Pragma("unroll") for (int ks = 0; ks < 2; ++ks) \
                KF[blk][ks] = *(const LAS bf16x8*)(lds + AT_KC + (32 * (c_) + kap0 + 4 * blk) * AT_KROW + ks * 64 + g * 16); \
            _Pragma("unroll") for (int db = 0; db < 4; ++db) VF[db] = *(const LAS bf16x8*)(lds + AT_VC + (16 * db + j) * AT_VROW + (c_) * 64 + g * 16); } while (0)
#define AT_EVALC(KF, VF, CB0) do { _Pragma("unroll") for (int cb = (CB0); cb < (CB0) + 2; ++cb) { f32x4 s_[2]; \
            _Pragma("unroll") for (int blk = 0; blk < 2; ++blk) { s_[blk] = __builtin_amdgcn_mfma_f32_16x16x32_bf16(KF[blk][0], qf[cb][0], (f32x4){0.f, 0.f, 0.f, 0.f}, 0, 0, 0); \
                s_[blk] = __builtin_amdgcn_mfma_f32_16x16x32_bf16(KF[blk][1], qf[cb][1], s_[blk], 0, 0, 0); } \
            float pv[8]; _Pragma("unroll") for (int t = 0; t < 8; ++t) { pv[t] = __builtin_amdgcn_exp2f(s_[t >> 2][t & 3]); l[cb] += pv[t]; } \
            u32x4 pw; pw.x = pk_bf16(pv[0], pv[1]); pw.y = pk_bf16(pv[2], pv[3]); pw.z = pk_bf16(pv[4], pv[5]); pw.w = pk_bf16(pv[6], pv[7]); \
            const bf16x8 pf = __builtin_bit_cast(bf16x8, pw); \
            _Pragma("unroll") for (int db = 0; db < 4; ++db) O[cb][db] = __builtin_amdgcn_mfma_f32_16x16x32_bf16(VF[db], pf, O[cb][db], 0, 0, 0); \
            if (cb & 1) __builtin_amdgcn_sched_barrier(0); } } while (0)
        {
            bf16x8 kfa[2][2], vfa[4], kfb[2][2], vfb[4];
            AT_LOADW(kfa, vfa, rs, 0);
            for (int i = 0; i < 8; ++i) {
                const int krow = rs + i;
                const unsigned tbrow = (unsigned)(AT_TB + (krow - r + 7) * 128);
                AT_LOADW(kfb, vfb, krow, 1);
                __builtin_amdgcn_sched_barrier(0);
                AT_EVALW(kfa, vfa, 0);
                AT_LOADC(kfa, vfa, i);
                AT_EVALC(kfa, vfa, 0);
                { const int kn = i < 7 ? krow + 1 : krow; AT_LOADW(kfa, vfa, kn, 0); }
                __builtin_amdgcn_sched_barrier(0);
                AT_EVALW(kfb, vfb, 1);
                AT_LOADC(kfb, vfb, i);
                AT_EVALC(kfb, vfb, 2);
            }
        }
#undef AT_LOADW
#undef AT_EVALW
#undef AT_LOADC
#undef AT_EVALC
#pragma unroll
        for (int cb = 0; cb < 4; ++cb) {
            float lt = l[cb]; lt += __shfl_xor(lt, 16); lt += __shfl_xor(lt, 32);
            const float inv = 1.0f / lt;
            const size_t qtok = (size_t)b * SEQ + r * 64 + 16 * cb + j;
#pragma unroll
            for (int db = 0; db < 4; ++db) { const f32x4 o = O[cb][db] * inv; u32x2 w; w.x = pk_bf16(o[0], o[1]); w.y = pk_bf16(o[2], o[3]);
                *(u32x2*)(MIX + qtok * DM + h * 64 + 16 * db + 4 * g) = w; }
        }
    }
    __syncthreads();
}

DEV float fast_sigmoid(float z) { return __builtin_amdgcn_rcpf(1.0f + __builtin_amdgcn_exp2f(-LOG2E * z)); }
struct LruGates { f32x16 acc[4]; f32x16 xc; bool poly; };
DEV void lru_xload(const bf16_t* xb, int T, int p0, int cg, int lane, u32x4 (&xw)[4][4], int& okm) {
    const int blk = cg >> 1, i = lane & 31, hh = lane >> 5;
    const int pos = p0 + 16 * ((i >> 2) & 1) + 4 * (i >> 3) + (i & 3);
    okm = 0;
#pragma unroll
    for (int tap = 0; tap < 4; ++tap) { const int pp = pos + tap - 2, pr = clampi(pp, 0, T - 1); okm |= (pp == pr) ? (1 << tap) : 0;
#pragma unroll
        for (int ks = 0; ks < 4; ++ks) xw[ks][tap] = *(const u32x4*)(xb + (size_t)pr * 512 + 64 * blk + 16 * ks + 8 * hh); }
}
DEV void lru_gates(const P& p, const LAS float* cw, int cg, int lane, const u32x4 (&xw)[4][4], int okm, const float (&la8)[2], LruGates& G) {
    const int blk = cg >> 1, half = cg & 1, i = lane & 31, hh = lane >> 5;
    const bf16_t* wgt = (const bf16_t*)(p.ws + WS_WGT) + (size_t)(blk * 64 + 32 * half + i) * 64 + 8 * hh;
#pragma unroll
    for (int gd = 0; gd < 4; ++gd)
#pragma unroll
        for (int q = 0; q < 16; ++q) G.acc[gd][q] = 0.f;
#pragma unroll
    for (int q = 0; q < 16; ++q) G.xc[q] = 0.f;
#pragma unroll
    for (int ks = 0; ks < 4; ++ks) {
        bf16x8 bw[4];
#pragma unroll
        for (int gd = 0; gd < 4; ++gd) bw[gd] = *(const bf16x8*)(wgt + gd * (8 * 64 * 64) + 16 * ks);
        const int ch0 = 64 * blk + 16 * ks + 8 * hh;
        float xc[8];
        { const f32x4 b0 = *(const LAS f32x4*)(cw + 2048 + ch0), b1 = *(const LAS f32x4*)(cw + 2048 + ch0 + 4);
          xc[0] = b0[0]; xc[1] = b0[1]; xc[2] = b0[2]; xc[3] = b0[3]; xc[4] = b1[0]; xc[5] = b1[1]; xc[6] = b1[2]; xc[7] = b1[3]; }
#pragma unroll
        for (int tap = 0; tap < 4; ++tap) {
            const f32x4 w0 = *(const LAS f32x4*)(cw + tap * 512 + ch0), w1 = *(const LAS f32x4*)(cw + tap * 512 + ch0 + 4);
            u32x4 x = xw[ks][tap]; if (!((okm >> tap) & 1)) x = (u32x4){0u, 0u, 0u, 0u};
            xc[0] += w0[0] * bflo(x.x); xc[1] += w0[1] * bfhi(x.x); xc[2] += w0[2] * bflo(x.y); xc[3] += w0[3] * bfhi(x.y);
            xc[4] += w1[0] * bflo(x.z); xc[5] += w1[1] * bfhi(x.z); xc[6] += w1[2] * bflo(x.w); xc[7] += w1[3] * bfhi(x.w);
        }
        u32x4 aw; aw.x = pk_bf16(xc[0], xc[1]); aw.y = pk_bf16(xc[2], xc[3]); aw.z = pk_bf16(xc[4], xc[5]); aw.w = pk_bf16(xc[6], xc[7]);
        const bf16x8 af = __builtin_bit_cast(bf16x8, aw);
#pragma unroll
        for (int gd = 0; gd < 4; ++gd) G.acc[gd] = __builtin_amdgcn_mfma_f32_32x32x16_bf16(af, bw[gd], G.acc[gd], 0, 0, 0);
        if ((ks >> 1) == half) {
            const int tt = i - 16 * (ks & 1) - 8 * hh;
            u32x4 idw = (u32x4){0u, 0u, 0u, 0u};
            const unsigned one = (tt >= 0 && tt < 8) ? (0x3F80u << (16 * (tt & 1))) : 0u;
            idw.x = (tt >> 1) == 0 ? one : 0u; idw.y = (tt >> 1) == 1 ? one : 0u; idw.z = (tt >> 1) == 2 ? one : 0u; idw.w = (tt >> 1) == 3 ? one : 0u;
            G.xc = __builtin_amdgcn_mfma_f32_32x32x16_bf16(af, __builtin_bit_cast(bf16x8, idw), G.xc, 0, 0, 0);
        }
        __builtin_amdgcn_sched_barrier(0);
    }
    asm volatile("s_nop 15\n\ts_nop 15" ::: "memory");
    __builtin_amdgcn_sched_barrier(0);
    G.poly = !__any((la8[0] < -0.25f) || (la8[1] < -0.25f));
}
DEV void lru_elem(const LruGates& G, int r, int d, const float (&la8)[2], const float (&br)[2], const float (&bi)[2], float& a, float& bt) {
    const float rg = fast_sigmoid(G.acc[2 * d][r] + br[d]), ig = fast_sigmoid(G.acc[2 * d + 1][r] + bi[d]);
    const float x = rg * la8[d]; float m;
    if (G.poly) { const float e1 = x * (1.0f + x * (0.5f + x * (0.16666667f + x * (0.041666668f + x * 0.0083333338f)))); a = 1.0f + e1; m = -e1 * (2.0f + e1); }
    else { a = __builtin_amdgcn_exp2f(LOG2E * x); m = 1.0f - __builtin_amdgcn_exp2f(2.0f * LOG2E * x); }
    bt = __builtin_amdgcn_sqrtf(m) * ig * G.xc[r];
}
DEV void lru_load_w(const P& p, int cg, int lane, float (&la8)[2], float (&br)[2], float (&bi)[2]) {
    const int c = 64 * (cg >> 1) + 32 * (cg & 1) + (lane & 31);
#pragma unroll
    for (int d = 0; d < 2; ++d) { la8[d] = ((const float*)(p.ws + WS_LA8))[d * 512 + c]; br[d] = p.gr_b[d * 512 + c]; bi[d] = p.gi_b[d * 512 + c]; }
}
DEV void phase_lru1(const P& p, LAS unsigned char* lds) {
    const int tid = tid_(), lane = tid & 63, wid = __builtin_amdgcn_readfirstlane(tid >> 6);
    const int gw = (int)blockIdx.x * 8 + wid, GW = (int)gridDim.x * 8;
    const int cg = gw & 15, hh = lane >> 5;
    LAS float* cw = (LAS float*)lds;
    for (int q = tid; q < 2560; q += NTHREADS) cw[q] = q < 2048 ? p.conv_w[q] : p.conv_b[q - 2048];
    __syncthreads();
    float la8[2], br[2], bi[2];
    lru_load_w(p, cg, lane, la8, br, bi);
    const bf16_t* XB = (const bf16_t*)(p.ws + WS_R + R_XB); const bf16_t* XBC = (const bf16_t*)(p.ws + WS_R + R_XBC);
    float2* SUM = (float2*)(p.ws + WS_SUM);
    unsigned* AB = (unsigned*)p.out;
    const int c = 64 * (cg >> 1) + 32 * (cg & 1) + (lane & 31);
    const int it0 = gw >> 4, itS = GW >> 4;
    u32x4 xw[4][4]; int okm = 0;
    if (it0 < NB * 136) { const int b = it0 / 136, tile = it0 - 136 * b; const bool isc = tile < 8;
        lru_xload(isc ? XBC + (size_t)b * CTXL * 512 : XB + (size_t)b * SEQ * 512, isc ? CTXL : SEQ, isc ? 32 * tile : 32 * (tile - 8), cg, lane, xw, okm); }
    for (int it = it0; it < NB * 136; it += itS) {
        const int b = it / 136, tile = it - 136 * b;
        const bool isc = tile < 8;
        int ln = lane; asm volatile("" : "+v"(ln));
        LruGates G; lru_gates(p, cw, cg, ln, xw, okm, la8, G);
        { const int itn = it + itS;
          if (itn < NB * 136) { const int bn = itn / 136, tn = itn - 136 * bn; const bool iscn = tn < 8;
              lru_xload(iscn ? XBC + (size_t)bn * CTXL * 512 : XB + (size_t)bn * SEQ * 512, iscn ? CTXL : SEQ, iscn ? 32 * tn : 32 * (tn - 8), cg, lane, xw, okm); } }
        unsigned* ab = AB + ((size_t)((b * 128 + (tile - 8)) * 16 + cg) * 32) * 64 + ln;
        float Af = 1.f, Hf = 0.f, Ab = 1.f, Hb = 0.f;
#pragma unroll
        for (int rp = 0; rp < 8; ++rp) {
            float a0, t0, a1, t1; lru_elem(G, 2 * rp, 0, la8, br, bi, a0, t0); lru_elem(G, 2 * rp + 1, 0, la8, br, bi, a1, t1);
            const unsigned ua = pk_bf16(1.0f - a0, 1.0f - a1), ut = pk_bf16(t0, t1);
            if (!isc) { ab[(0 * 8 + rp) * 64] = ua; ab[(1 * 8 + rp) * 64] = ut; }
            a0 = 1.0f - bflo(ua); a1 = 1.0f - bfhi(ua); t0 = bflo(ut); t1 = bfhi(ut);
            Hf = a0 * Hf + t0; Af *= a0; Hf = a1 * Hf + t1; Af *= a1;
            __builtin_amdgcn_sched_barrier(0);
        }
#pragma unroll
        for (int rp = 7; rp >= 0; --rp) {
            float a0, t0, a1, t1; lru_elem(G, 2 * rp, 1, la8, br, bi, a0, t0); lru_elem(G, 2 * rp + 1, 1, la8, br, bi, a1, t1);
            const unsigned ua = pk_bf16(1.0f - a0, 1.0f - a1), ut = pk_bf16(t0, t1);
            if (!isc) { ab[(2 * 8 + rp) * 64] = ua; ab[(3 * 8 + rp) * 64] = ut; }
            a0 = 1.0f - bflo(ua); a1 = 1.0f - bfhi(ua); t0 = bflo(ut); t1 = bfhi(ut);
            Hb = a1 * Hb + t1; Ab *= a1; Hb = a0 * Hb + t0; Ab *= a0;
            __builtin_amdgcn_sched_barrier(0);
        }
        const float oAf = __shfl_xor(Af, 32), oHf = __shfl_xor(Hf, 32), oAb = __shfl_xor(Ab, 32), oHb = __shfl_xor(Hb, 32);
        const float Af_lo = hh ? oAf : Af, Hf_lo = hh ? oHf : Hf, Af_up = hh ? Af : oAf, Hf_up = hh ? Hf : oHf;
        const float Ab_lo = hh ? oAb : Ab, Hb_lo = hh ? oHb : Hb, Ab_up = hh ? Ab : oAb, Hb_up = hh ? Hb : oHb;
        const float2 fw = make_float2(Af_lo * Af_up, Af_up * Hf_lo + Hf_up);
        const float2 bw = make_float2(Ab_lo * Ab_up, Ab_lo * Hb_up + Hb_lo);
        SUM[((size_t)(b * 136 + tile) * 2 + (ln >> 5)) * 512 + 64 * (cg >> 1) + 32 * (cg & 1) + (ln & 31)] = (ln >> 5) ? bw : fw;
    }
}
DEV void phase_lru_carry(const P& p) {
    const int tid = tid_(), lane = tid & 63;
    const int gwv = (int)blockIdx.x * 8 + __builtin_amdgcn_readfirstlane(tid >> 6);
    if (gwv >= NB * 2 * 64) return;
    const int seg = lane >> 3, c = (gwv & 63) * 8 + (lane & 7), dir = (gwv >> 6) & 1, b = gwv >> 7;
    const float2* SUM = (const float2*)(p.ws + WS_SUM); float* CAR = (float*)(p.ws + WS_CAR);
    float2 sv[17]; int tl[17];
#pragma unroll
    for (int q = 0; q < 17; ++q) { const int o = 17 * seg + q; tl[q] = dir == 0 ? o : (o < 8 ? 7 - o : 143 - o); sv[q] = SUM[((size_t)(b * 136 + tl[q]) * 2 + dir) * 512 + c]; }
    float A = 1.f, H = 0.f;
#pragma unroll
    for (int q = 0; q < 17; ++q) { H = sv[q].x * H + sv[q].y; A *= sv[q].x; }
    float h = 0.f, mine = 0.f;
#pragma unroll
    for (int sg = 0; sg < 8; ++sg) { const float As = __shfl(A, sg * 8 + (lane & 7)), Hs = __shfl(H, sg * 8 + (lane & 7)); if (sg == seg) mine = h; h = As * h + Hs; }
    h = mine;
#pragma unroll
    for (int q = 0; q < 17; ++q) { if (tl[q] >= 8) CAR[((size_t)(b * 128 + tl[q] - 8) * 2 + dir) * 512 + c] = h; h = sv[q].x * h + sv[q].y; }
}
DEV void phase_lru2(const P& p) {
    const int tid = tid_(), lane = tid & 63, wid = __builtin_amdgcn_readfirstlane(tid >> 6);
    const int gw = (int)blockIdx.x * 8 + wid, GW = (int)gridDim.x * 8;
    const int cg = gw & 15, hh = lane >> 5;
    const bf16_t* GB = (const bf16_t*)(p.ws + WS_R + R_GB);
    bf16_t* MIX = (bf16_t*)(p.ws + WS_R + R_MIX);
    const float* CAR = (const float*)(p.ws + WS_CAR);
    const unsigned* AB = (const unsigned*)p.out;
    const int c = 64 * (cg >> 1) + 32 * (cg & 1) + (lane & 31);
    for (int it = gw >> 4; it < NB * 128; it += GW >> 4) {
        const int b = it >> 7, tile = it & 127, p0 = 32 * tile;
        const unsigned* ab = AB + ((size_t)((b * 128 + tile) * 16 + cg) * 32) * 64 + lane;
        unsigned u[4][8];
#pragma unroll
        for (int k = 0; k < 4; ++k)
#pragma unroll
            for (int rp = 0; rp < 8; ++rp) u[k][rp] = ab[(k * 8 + rp) * 64];
        const float cf = CAR[((size_t)(b * 128 + tile) * 2 + 0) * 512 + c], cbk = CAR[((size_t)(b * 128 + tile) * 2 + 1) * 512 + c];
        unsigned short gbv[16];
#pragma unroll
        for (int r = 0; r < 16; ++r) gbv[r] = GB[((size_t)b * SEQ + p0 + 16 * hh + r) * 512 + c];
        float y[16], Pf[16], Pb[16];
        float Af = 1.f, Hf = 0.f, Ab = 1.f, Hb = 0.f;
#pragma unroll
        for (int rp = 0; rp < 8; ++rp) {
            const float a0 = 1.0f - bflo(u[0][rp]), a1 = 1.0f - bfhi(u[0][rp]), t0 = bflo(u[1][rp]), t1 = bfhi(u[1][rp]);
            Hf = a0 * Hf + t0; Af *= a0; y[2 * rp] = Hf; Pf[2 * rp] = Af;
            Hf = a1 * Hf + t1; Af *= a1; y[2 * rp + 1] = Hf; Pf[2 * rp + 1] = Af;
        }
#pragma unroll
        for (int rp = 7; rp >= 0; --rp) {
            const float a0 = 1.0f - bflo(u[2][rp]), a1 = 1.0f - bfhi(u[2][rp]), t0 = bflo(u[3][rp]), t1 = bfhi(u[3][rp]);
            Hb = a1 * Hb + t1; Ab *= a1; y[2 * rp + 1] += Hb; Pb[2 * rp + 1] = Ab;
            Hb = a0 * Hb + t0; Ab *= a0; y[2 * rp] += Hb; Pb[2 * rp] = Ab;
        }
        const float oAf = __shfl_xor(Af, 32), oHf = __shfl_xor(Hf, 32), oAb = __shfl_xor(Ab, 32), oHb = __shfl_xor(Hb, 32);
        const float sf = hh ? (oAf * cf + oHf) : cf;
        const float sb = hh ? cbk : (oAb * cbk + oHb);
#pragma unroll
        for (int r = 0; r < 16; ++r) { const size_t tok = (size_t)b * SEQ + p0 + 16 * hh + r;
            MIX[tok * DM + 512 + c] = f2bf(bf2f(gbv[r]) * (y[r] + Pf[r] * sf + Pb[r] * sb)); }
    }
}

DEV unsigned perm_lo(unsigned w1, unsigned w0) { return __builtin_amdgcn_perm(w1, w0, 0x05040100u); }
DEV unsigned perm_hi(unsigned w1, unsigned w0) { return __builtin_amdgcn_perm(w1, w0, 0x07060302u); }
DEV void phase_fnet_s1(const P& p, LAS unsigned char* lds) {
    const int tid = tid_(), lane = tid & 63, wid = __builtin_amdgcn_readfirstlane(tid >> 6);
    const int gw = (int)blockIdx.x * 8 + wid, GW = (int)gridDim.x * 8;
    const int jj = lane & 31, hh = lane >> 5;
    const bf16_t* F1 = (const bf16_t*)(p.ws + WS_F1); const bf16_t* H = (const bf16_t*)(p.ws + WS_XA);
    const float* PART = (const float*)(p.ws + WS_PART); const float* modl = (const float*)(p.ws + WS_MOD) + 9 * 6144; const float* gain = p.norm_mix + DM;
    LAS float* rsl = (LAS float*)lds + 64 * wid;
    bf16_t* T = (bf16_t*)(p.ws + WS_R + R_T); const float2* TW = (const float2*)(p.ws + WS_TW);
    bf16x8 Af[4][4];
#pragma unroll
    for (int ib = 0; ib < 4; ++ib)
#pragma unroll
        for (int ks = 0; ks < 4; ++ks) Af[ib][ks] = *(const bf16x8*)(F1 + (size_t)(32 * ib + jj) * 64 + 16 * ks + 8 * hh);
    for (int it = gw; it < NB * 64 * 16; it += GW) {
        const int cb = it & 15, n2 = (it >> 4) & 63, b = it >> 10;
        const int col = 64 * cb + 2 * jj;
        const bf16_t* hb = H + ((size_t)b * SEQ + n2) * DM + col;
        { const float* pr = PART + ((size_t)b * SEQ + 64 * lane + n2) * 16;
          const f32x4 a0 = *(const f32x4*)pr, a1 = *(const f32x4*)(pr + 4), a2 = *(const f32x4*)(pr + 8), a3 = *(const f32x4*)(pr + 12);
          const f32x4 a = (a0 + a1) + (a2 + a3);
          rsl[lane] = rsqrtf(((a[0] + a[1]) + (a[2] + a[3])) * (1.0f / 1024.0f) + 1e-6f); }
        const float2 g2 = *(const float2*)(gain + col), sc2 = *(const float2*)(modl + (size_t)b * 6144 + 1024 + col), sh2 = *(const float2*)(modl + (size_t)b * 6144 + col);
        const float gs0 = g2.x * (sc2.x + 1.0f), gs1 = g2.y * (sc2.y + 1.0f);
        __builtin_amdgcn_fence(__ATOMIC_RELEASE, "wavefront"); __builtin_amdgcn_wave_barrier(); __builtin_amdgcn_fence(__ATOMIC_ACQUIRE, "wavefront");
        bf16x8 Bf[2][4];
#pragma unroll
        for (int ks = 0; ks < 4; ++ks) {
            unsigned w[8];
#pragma unroll
            for (int t = 0; t < 8; ++t) w[t] = *(const unsigned*)(hb + (size_t)(64 * (16 * ks + 8 * hh + t)) * DM);
            const f32x4 r0 = *(const LAS f32x4*)(rsl + 16 * ks + 8 * hh), r1 = *(const LAS f32x4*)(rsl + 16 * ks + 8 * hh + 4);
            const float rv[8] = {r0[0], r0[1], r0[2], r0[3], r1[0], r1[1], r1[2], r1[3]};
            float h0[8], h1[8];
#pragma unroll
            for (int t = 0; t < 8; ++t) { h0[t] = bflo(w[t]) * rv[t] * gs0 + sh2.x; h1[t] = bfhi(w[t]) * rv[t] * gs1 + sh2.y; }
            u32x4 e0, e1;
            e0.x = pk_bf16(h0[0], h0[1]); e0.y = pk_bf16(h0[2], h0[3]); e0.z = pk_bf16(h0[4], h0[5]); e0.w = pk_bf16(h0[6], h0[7]);
            e1.x = pk_bf16(h1[0], h1[1]); e1.y = pk_bf16(h1[2], h1[3]); e1.z = pk_bf16(h1[4], h1[5]); e1.w = pk_bf16(h1[6], h1[7]);
            Bf[0][ks] = __builtin_bit_cast(bf16x8, e0); Bf[1][ks] = __builtin_bit_cast(bf16x8, e1);
        }
        __builtin_amdgcn_wave_barrier();
#pragma unroll
        for (int ib2 = 0; ib2 < 2; ++ib2) {
            f32x16 D[2][2];
#pragma unroll
            for (int st = 0; st < 2; ++st)
#pragma unroll
                for (int ri = 0; ri < 2; ++ri) {
#pragma unroll
                    for (int q = 0; q < 16; ++q) D[st][ri][q] = 0.f;
#pragma unroll
                    for (int ks = 0; ks < 4; ++ks) D[st][ri] = __builtin_amdgcn_mfma_f32_32x32x16_bf16(Af[ib2 + 2 * ri][ks], Bf[st][ks], D[st][ri], 0, 0, 0);
                }
            asm volatile("s_nop 15\n\ts_nop 15" ::: "memory");
            __builtin_amdgcn_sched_barrier(0);
#pragma unroll
            for (int r = 0; r < 16; ++r) {
                const int k1 = 32 * ib2 + (r & 3) + 8 * (r >> 2) + 4 * hh;
                const float2 tw = TW[n2 * 64 + k1];
                const float tr0 = D[0][0][r] * tw.x + D[0][1][r] * tw.y, ti0 = D[0][1][r] * tw.x - D[0][0][r] * tw.y;
                const float tr1 = D[1][0][r] * tw.x + D[1][1][r] * tw.y, ti1 = D[1][1][r] * tw.x - D[1][0][r] * tw.y;
                unsigned char* tp = (unsigned char*)T + ((size_t)b * SEQ + k1 * 64 + n2) * 2048 + col;
                *(unsigned short*)tp = (unsigned short)pk2_fp8(tr0, tr1); *(unsigned short*)(tp + 1024) = (unsigned short)pk2_fp8(ti0, ti1);
            }
        }
    }
}
DEV void phase_fnet_s2(const P& p) {
    const int tid = tid_(), lane = tid & 63, wid = __builtin_amdgcn_readfirstlane(tid >> 6);
    const int gw = (int)blockIdx.x * 8 + wid, GW = (int)gridDim.x * 8;
    const int jj = lane & 31, hh = lane >> 5;
    const bf16_t* F2 = (const bf16_t*)(p.ws + WS_F2);
    const bf16_t* T = (const bf16_t*)(p.ws + WS_R + R_T); bf16_t* Y = (bf16_t*)(p.ws + WS_R + R_Y);
    bf16x8 Af[2][8];
#pragma unroll
    for (int ib = 0; ib < 2; ++ib)
#pragma unroll
        for (int ks = 0; ks < 8; ++ks) Af[ib][ks] = *(const bf16x8*)(F2 + (size_t)ib * 64 * 128 + (size_t)jj * 128 + 16 * ks + 8 * hh);
    for (int it = gw; it < NB * 64 * 16; it += GW) {
        const int cb = it & 15, k1 = (it >> 4) & 63, b = it >> 10;
        const int col = 64 * cb + 2 * jj;
        const unsigned char* tb = (const unsigned char*)T + ((size_t)b * SEQ + k1 * 64) * 2048 + col;
        f32x16 D[2][2];
#pragma unroll
        for (int st = 0; st < 2; ++st)
#pragma unroll
            for (int ib = 0; ib < 2; ++ib)
#pragma unroll
                for (int q = 0; q < 16; ++q) D[st][ib][q] = 0.f;
#pragma unroll
        for (int ks = 0; ks < 8; ++ks) {
            unsigned short w[8];
#pragma unroll
            for (int t = 0; t < 8; ++t) { const int kk = 16 * ks + 8 * hh + t; w[t] = *(const unsigned short*)(tb + (size_t)(kk & 63) * 2048 + (kk >> 6) * 1024); }
            f32x2 f[8];
#pragma unroll
            for (int t = 0; t < 8; ++t) f[t] = __builtin_amdgcn_cvt_pk_f32_fp8((int)w[t], false);
            u32x4 e0, e1;
            e0.x = pk_bf16(f[0][0], f[1][0]); e0.y = pk_bf16(f[2][0], f[3][0]); e0.z = pk_bf16(f[4][0], f[5][0]); e0.w = pk_bf16(f[6][0], f[7][0]);
            e1.x = pk_bf16(f[0][1], f[1][1]); e1.y = pk_bf16(f[2][1], f[3][1]); e1.z = pk_bf16(f[4][1], f[5][1]); e1.w = pk_bf16(f[6][1], f[7][1]);
            const bf16x8 b0 = __builtin_bit_cast(bf16x8, e0), b1 = __builtin_bit_cast(bf16x8, e1);
#pragma unroll
            for (int ib = 0; ib < 2; ++ib) { D[0][ib] = __builtin_amdgcn_mfma_f32_32x32x16_bf16(Af[ib][ks], b0, D[0][ib], 0, 0, 0); D[1][ib] = __builtin_amdgcn_mfma_f32_32x32x16_bf16(Af[ib][ks], b1, D[1][ib], 0, 0, 0); }
        }
        asm volatile("s_nop 15\n\ts_nop 15" ::: "memory");
        __builtin_amdgcn_sched_barrier(0);
#pragma unroll
        for (int ib = 0; ib < 2; ++ib)
#pragma unroll
            for (int r = 0; r < 16; ++r) {
                const int k2 = (r & 3) + 8 * (r >> 2) + 4 * hh;
                *(unsigned short*)((unsigned char*)Y + ((size_t)b * 2048 + k1 + 64 * k2) * 2048 + ib * 1024 + col) = (unsigned short)pk2_fp8(D[0][ib][r] * F8_SY, D[1][ib][r] * F8_SY);
            }
        if (k1 == 0 && hh == 0) {
            float a0 = 0.f, a1 = 0.f;
#pragma unroll 8
            for (int n2 = 0; n2 < 64; ++n2) { const f32x2 v = __builtin_amdgcn_cvt_pk_f32_fp8((int)*(const unsigned short*)(tb + (size_t)n2 * 2048), false); a0 += (n2 & 1) ? -v[0] : v[0]; a1 += (n2 & 1) ? -v[1] : v[1]; }
            *(float2*)((float*)(p.ws + WS_Y2048) + b * 1024 + col) = make_float2(a0, a1);
        }
    }
}

constexpr int LDS_BYTES = 144 * 1024;
constexpr int LDS_BARW = 128 * 1024;
constexpr int LDS_TAB = 128 * 1024 + 64;
constexpr int NPHASE = 18;

template <int PH, bool DUMMY = false>
DEV void run_phase(const P& p, LAS unsigned char* lds) {
    void* const dummy_out = (void*)(p.ws + WS_R + 128 * MB_);
    bf16_t* const dummy_out13 = (bf16_t*)(p.ws + WS_R + R_T);
    bf16_t* const XA = (bf16_t*)(p.ws + WS_XA);
    const float* mod0 = (const float*)(p.ws + WS_MOD); const float* mod1 = mod0 + 9 * 6144;
    if constexpr (PH == 0) phase_prologue(p, lds);
    const bool ctx1 = gridDim.x >= CTX_D0 + 48;
    if constexpr (PH == 1) {
        if (ctx1) {
            const int bid = (int)blockIdx.x, dd = bid - CTX_D0;
            unsigned* done = (unsigned*)(p.ws + WS_CNT + 12 * KB_);
            phase_norm_plain<true, false, true>(p, p.x, MTOK, MALL, bid, (int)gridDim.x, p.norm_mix, mod0, 0, 1024);
            asm volatile("s_waitcnt vmcnt(0)" ::: "memory"); __syncthreads();
            if (threadIdx.x == 0) { __builtin_amdgcn_fence(__ATOMIC_RELEASE, "agent"); (void)xb_add(done, 1u); }
            { JobFold J{p}; g8::gemm_phase(lds, J); } phase_mod_final(p);
            if (dd >= 0 && dd < 48) {
                if (threadIdx.x == 0) { unsigned sp = 0; while (xb_ld(done) < gridDim.x && ++sp < XB_SPIN_CAP) __builtin_amdgcn_s_sleep(2); __builtin_amdgcn_fence(__ATOMIC_ACQUIRE, "agent"); }
                __syncthreads();
                const int t = dd >> 3;
                if (t < 2) { JobInProj<false, true> J{p, 2}; g8::gemm_phase(lds, J); } else if (t < 4) { JobInProj<true, true> J{p, 2}; g8::gemm_phase(lds, J); } else { JobInProj<false, false> J{p, 2}; g8::gemm_phase(lds, J); }
            }
            phase_norm_plain<true, false, true>(p, p.x, 0, MTOK, dd < 48 ? -1 : bid - (CTX_D0 + 48), (int)gridDim.x - (CTX_D0 + 48), p.norm_mix, mod0, 0, 1024);
        } else { { JobFold J{p}; g8::gemm_phase(lds, J); } phase_mod_final(p); phase_norm_plain<true, false, true>(p, p.x, 0, MALL, (int)blockIdx.x, (int)gridDim.x, p.norm_mix, mod0, 0, 1024); } }
    if constexpr (PH == 2) { const int md = ctx1 ? 1 : 0; { JobInProj<false, true> J{p, md}; g8::gemm_phase(lds, J); } { JobInProj<true, true> J{p, md}; g8::gemm_phase(lds, J); } { JobInProj<false, false> J{p, md}; g8::gemm_phase(lds, J); } }
    if constexpr (PH == 3) { phase_attention(p, lds); phase_lru1(p, lds); }
    if constexpr (PH == 4) phase_lru_carry(p);
    if constexpr (PH == 5) phase_lru2(p);
    if constexpr (PH == 6) { JobResid<1024, false> J{(const bf16_t*)(p.ws + WS_R + R_MIX), (const bf16_t*)(p.ws + WS_WOUT), p.x, XA, mod0 + 2048}; g8::gemm_phase(lds, J); }
    if constexpr (PH == 7) phase_norm_router(p, lds, XA, p.norm_ffn, mod0, DUMMY ? 2 : 0);
    if constexpr (PH == 8) { moe_build_tab((const unsigned*)(p.ws + WS_CNT), (LAS MoeTab*)(lds + LDS_TAB));
        { JobGateUp J{p, 0, (const LAS MoeTab*)(lds + LDS_TAB)}; g8::gemm_phase(lds, J); }
        { JobDown<false> J{p, 0, (const LAS MoeTab*)(lds + LDS_TAB), DUMMY ? dummy_out : (void*)XA}; g8::gemm_phase(lds, J); } }
    if constexpr (PH == 9) { }
    if constexpr (PH == 10) { }
    if constexpr (PH == 11) phase_fnet_s1(p, lds);
    if constexpr (PH == 12) phase_fnet_s2(p);
    if constexpr (PH == 13) { { JobHerm<0> J{p, XA}; g8::gemm_phase(lds, J); } asm volatile("s_waitcnt vmcnt(0)" ::: "memory"); __syncthreads(); { JobHerm<1> J{p, XA}; g8::gemm_phase(lds, J); } phase_herm_row2048(p, lds, XA); }
    if constexpr (PH == 14) { }
    if constexpr (PH == 15) phase_norm_router(p, lds, XA, p.norm_ffn + DM, mod1, DUMMY ? 3 : 1);
    if constexpr (PH == 16) { moe_build_tab((const unsigned*)(p.ws + WS_CNT) + 1024, (LAS MoeTab*)(lds + LDS_TAB));
        { JobGateUp J{p, 1, (const LAS MoeTab*)(lds + LDS_TAB)}; g8::gemm_phase(lds, J); }
        { JobDown<true> J{p, 1, (const LAS MoeTab*)(lds + LDS_TAB), DUMMY ? dummy_out : (void*)p.out}; g8::gemm_phase(lds, J); } }
    if constexpr (PH == 17) { }
}

#if MK_MULTI
template <int PH> __global__ void __launch_bounds__(NTHREADS, 2) k_phase(P p) {
    extern __shared__ __attribute__((aligned(16))) unsigned char shm[];
    run_phase<PH>(p, (LAS unsigned char*)shm);
}
template <int PH> static void launch_one(const P& p, int grid, hipStream_t s) {
    static bool attr = false; if (!attr) { (void)hipFuncSetAttribute((const void*)k_phase<PH>, hipFuncAttributeMaxDynamicSharedMemorySize, LDS_BYTES); attr = true; }
    hipLaunchKernelGGL((k_phase<PH>), dim3(grid), dim3(NTHREADS), LDS_BYTES, s, p);
}
template <int PH> static void launch_all(const P& p, int grid, hipStream_t s) { launch_one<PH>(p, grid, s); if constexpr (PH + 1 < NPHASE && PH < MK_LAST_PHASE) launch_all<PH + 1>(p, grid, s); }
#else
DEV P load_params() {
    typedef const unsigned long long __attribute__((address_space(4))) * KP;
    KP pp = (KP)__builtin_amdgcn_kernarg_segment_ptr();
    asm volatile("" : "+s"(pp));
    P r;
    typedef const float __attribute__((address_space(1))) * GF; typedef float __attribute__((address_space(1))) * GFW; typedef unsigned char __attribute__((address_space(1))) * GB;
#define LP_(i, f) r.f = (const float*)(GF)pp[i]
    LP_(0, x); LP_(1, c); LP_(2, ctx); LP_(3, c_ctx); LP_(4, ada_w); LP_(5, ada_b); LP_(6, norm_mix); LP_(7, norm_ffn); LP_(8, mix_w_in); LP_(9, mix_w_out); LP_(10, qn); LP_(11, kn); LP_(12, rpb);
    LP_(13, conv_w); LP_(14, conv_b); LP_(15, gr_w); LP_(16, gr_b); LP_(17, gi_w); LP_(18, gi_b); LP_(19, lam); LP_(20, fnet_w); LP_(21, router_w); LP_(22, router_b); LP_(23, wg); LP_(24, wu); LP_(25, wd);
#undef LP_
    r.out = (float*)(GFW)pp[26]; r.ws = (unsigned char*)(GB)pp[27];
    return r;
}
template <int PH> DEV void run_all(LAS unsigned char* lds) {
#ifdef MK_REP_MASK
    if constexpr (((MK_REP_MASK) >> PH) & 1) {
        { const P p = load_params(); run_phase<PH, true>(p, lds); }
        { const P pb = load_params(); XcdBarrier bar; bar.bar = (unsigned*)(pb.ws + WS_BAR); bar.x = xb_xcc_id(); bar.st = (volatile LAS unsigned*)(lds + LDS_BARW); xcd_barrier(bar); }
    }
#endif
    { const P p = load_params(); run_phase<PH>(p, lds); }
    if constexpr (PH + 1 < NPHASE && PH < MK_LAST_PHASE) {
        if constexpr (PH != 13 && PH != 9 && PH != 8 && PH != 16) { const P pb = load_params();
          XcdBarrier bar; bar.bar = (unsigned*)(pb.ws + WS_BAR); bar.x = xb_xcc_id(); bar.st = (volatile LAS unsigned*)(lds + LDS_BARW);
          xcd_barrier(bar); }
        run_all<PH + 1>(lds);
    }
}
__global__ void __launch_bounds__(NTHREADS, 2) k_mega(P p) {
    extern __shared__ __attribute__((aligned(16))) unsigned char shm[];
    LAS unsigned char* lds = (LAS unsigned char*)shm;
    if (threadIdx.x == 0) *(LAS u32x4*)(lds + LDS_BARW) = (u32x4){0u, 0u, 0u, 0u};
    __syncthreads();
    (void)xcd_barrier_post((unsigned*)(p.ws + WS_BAR), (volatile LAS unsigned*)(lds + LDS_BARW));
    run_all<0>(lds);
}
#endif

extern "C" void kernel_launch(void* const* d_in, const int* in_sizes, int n_in, void* d_out, int out_size, void* d_ws, size_t ws_size, hipStream_t stream) {
    static int grid = 0;
    if (grid == 0) {
        if (n_in != 26 || out_size != MTOK * DM || ws_size < WS_END) { fprintf(stderr, "kernel_launch: unexpected problem (n_in %d out %d ws %zu need %zu)\n", n_in, out_size, ws_size, (size_t)WS_END); grid = -1; return; }
        int dev = 0, cus = 0; (void)hipGetDevice(&dev); (void)hipDeviceGetAttribute(&cus, hipDeviceAttributeMultiprocessorCount, dev);
#if !MK_MULTI
        if (hipFuncSetAttribute((const void*)k_mega, hipFuncAttributeMaxDynamicSharedMemorySize, LDS_BYTES) != hipSuccess) { fprintf(stderr, "kernel_launch: hipFuncSetAttribute failed\n"); grid = -1; return; }
        int per_cu = 0; (void)hipOccupancyMaxActiveBlocksPerMultiprocessor(&per_cu, (const void*)k_mega, NTHREADS, LDS_BYTES);
        if (per_cu < 1) { fprintf(stderr, "kernel_launch: occupancy query says %d blocks per CU\n", per_cu); }
#endif
        grid = cus > 0 ? (cus / 8) * 8 : 256; if (grid < 8) grid = 8;
    }
    if (grid < 0) return;
    P p{};
    const float** f = (const float**)&p;
    for (int i = 0; i < 26; ++i) f[i] = (const float*)d_in[i];
    p.out = (float*)d_out; p.ws = (unsigned char*)d_ws;
    (void)hipMemsetAsync(d_ws, 0, WS_ZERO_BYTES, stream);
#if MK_MULTI
    launch_all<0>(p, grid, stream);
#else
    hipLaunchKernelGGL(k_mega, dim3(grid), dim3(NTHREADS), LDS_BYTES, stream, p);
#endif
}
```

```cpp
#include <hip/hip_runtime.h>
#include <stdint.h>
#include <stdio.h>

#ifndef MK_MULTI
#define MK_MULTI 0
#endif

#ifndef MK_LAST_PHASE
#define MK_LAST_PHASE 17
#endif
#define DEV __device__ __forceinline__
#define LAS __attribute__((address_space(3)))
typedef unsigned short bf16_t;
typedef short bf16x8 __attribute__((ext_vector_type(8)));
typedef float f32x2 __attribute__((ext_vector_type(2)));
typedef float f32x4 __attribute__((ext_vector_type(4)));
typedef float f32x16 __attribute__((ext_vector_type(16)));
typedef unsigned u32x4 __attribute__((ext_vector_type(4)));
typedef unsigned u32x2 __attribute__((ext_vector_type(2)));
typedef int i32x8 __attribute__((ext_vector_type(8)));
typedef int i32x4 __attribute__((ext_vector_type(4)));

constexpr int DM = 1024, NB = 8, SEQ = 4096, MTOK = NB * SEQ, CTXL = 256, MCTX = NB * CTXL, MALL = MTOK + MCTX;
constexpr int NPAIR = 24, LISTCAP = 32768, HIDROWS = 38912;
constexpr float LOG2E = 1.4426950408889634f;
constexpr int NTHREADS = 512;

constexpr size_t KB_ = 1024, MB_ = 1024 * 1024;
constexpr size_t WS_BAR   = 0;
constexpr size_t WS_CNT   = 16 * KB_;
constexpr size_t WS_MOD   = 64 * KB_;
constexpr size_t WS_ZERO_BYTES = 512 * KB_;
constexpr size_t WS_RPB2  = 512 * KB_;
constexpr size_t WS_LA8   = WS_RPB2 + 16 * KB_;
constexpr size_t WS_F1    = WS_LA8 + 4 * KB_;
constexpr size_t WS_F2    = WS_F1 + 16 * KB_;
constexpr size_t WS_TW    = WS_F2 + 32 * KB_;
constexpr size_t WS_CS    = WS_TW + 32 * KB_;
constexpr size_t WS_WGT   = WS_CS + 256 * KB_;
constexpr size_t WS_Y2048 = 1536 * KB_;
constexpr size_t WS_WIN   = 2 * MB_;
constexpr size_t WS_WOUT  = WS_WIN + 5 * MB_;
constexpr size_t WS_WF    = WS_WOUT + 2 * MB_;
constexpr size_t WS_WFOLD = WS_WF + 2 * MB_;
constexpr size_t WS_WGU   = WS_WFOLD + 4 * MB_;
constexpr size_t WS_WD    = WS_WGU + 64 * MB_;
constexpr size_t WS_PART  = WS_WD + 16 * MB_;
constexpr size_t WS_H     = WS_WD + 32 * MB_;
constexpr size_t WS_LIST  = WS_H + 68 * MB_;
constexpr size_t WS_SLOTW = WS_LIST + 3 * MB_;
constexpr size_t WS_R     = WS_SLOTW + 6 * MB_;
constexpr size_t WS_SUM   = WS_R + 256 * MB_;
constexpr size_t WS_CAR   = WS_SUM + 9 * MB_;
constexpr size_t WS_MODP  = WS_CAR + 4 * MB_;
constexpr size_t WS_XA    = WS_SUM;
constexpr size_t WS_END   = WS_XA + 64 * MB_;
constexpr size_t R_Q = 0, R_K = 32 * MB_, R_VT = 64 * MB_, R_XB = 96 * MB_, R_GB = 128 * MB_, R_KC = 160 * MB_, R_VCT = 162 * MB_, R_XBC = 164 * MB_, R_MIX = 166 * MB_;
constexpr size_t R_T = 0, R_Y = 128 * MB_;
constexpr size_t R_P = 0;
constexpr size_t R_HID = 0;

struct P {
    const float *x, *c, *ctx, *c_ctx, *ada_w, *ada_b, *norm_mix, *norm_ffn, *mix_w_in, *mix_w_out, *qn, *kn, *rpb, *conv_w, *conv_b,
                *gr_w, *gr_b, *gi_w, *gi_b, *lam, *fnet_w, *router_w, *router_b, *wg, *wu, *wd;
    float* out; unsigned char* ws;
};

typedef __bf16 bf16v2_ __attribute__((ext_vector_type(2)));
typedef float f32v2_ __attribute__((ext_vector_type(2)));
DEV unsigned pk_bf16(float lo, float hi) { const f32v2_ v = {lo, hi}; const bf16v2_ b = __builtin_convertvector(v, bf16v2_); return __builtin_bit_cast(unsigned, b); }
DEV unsigned pk_bf16_asm(float lo, float hi) { unsigned r; asm("v_cvt_pk_bf16_f32 %0, %1, %2" : "=v"(r) : "v"(lo), "v"(hi)); return r; }
DEV bf16_t f2bf(float f) { return (bf16_t)(pk_bf16(f, 0.f) & 0xffffu); }
DEV float bf2f(bf16_t b) { return __uint_as_float(((unsigned)b) << 16); }
DEV float bflo(unsigned w) { return __uint_as_float(w << 16); }
DEV float bfhi(unsigned w) { return __uint_as_float(w & 0xffff0000u); }
DEV float sigmoidf_(float z) { return __builtin_amdgcn_rcpf(1.0f + __builtin_amdgcn_exp2f(-LOG2E * z)); }
DEV float gelu_tanh(float x) { const float u = 0.7978845608028654f * (x + 0.044715f * x * x * x); return x * __builtin_amdgcn_rcpf(1.0f + __builtin_amdgcn_exp2f(-2.0f * LOG2E * u)); }
DEV float clamp448(float v) { return fminf(fmaxf(v, -448.0f), 448.0f); }
DEV unsigned pk4_fp8(float a, float b, float c, float d) { unsigned w = 0u; w = (unsigned)__builtin_amdgcn_cvt_pk_fp8_f32(clamp448(a), clamp448(b), (int)w, false); w = (unsigned)__builtin_amdgcn_cvt_pk_fp8_f32(clamp448(c), clamp448(d), (int)w, true); return w; }
constexpr float F8_SH = 8.0f, F8_SW = 64.0f, F8_SHID = 8.0f;
constexpr float F8_SY = 0.0625f, F8_SWF = 32768.0f;
DEV unsigned pk2_fp8(float a, float b) { return (unsigned)__builtin_amdgcn_cvt_pk_fp8_f32(clamp448(a), clamp448(b), 0, false) & 0xffffu; }
DEV int clampi(int v, int lo, int hi) { return v < lo ? lo : (v > hi ? hi : v); }
DEV int l8row(int c) { return (c & ~31) + 16 * ((c >> 2) & 1) + 4 * ((c >> 3) & 3) + (c & 3); }
DEV int tid_() { int t = (int)threadIdx.x; asm volatile("" : "+v"(t)); return t; }

#define XB_TMO      128
#define XB_XCNT(j)  (256  + 64 * (j))
#define XB_XSUB(j)  (1280 + 64 * (j))
#define XB_XGEN(j)  (2304 + 64 * (j))
#define XB_TOP      3328
#define XB_TOPGEN   3392
#define XCD_BAR_WORDS 3456
#define XB_SPIN_CAP (1u << 22)
DEV unsigned xb_ld(unsigned* p)              { return __hip_atomic_load(p, __ATOMIC_RELAXED, __HIP_MEMORY_SCOPE_AGENT); }
DEV unsigned xb_add(unsigned* p, unsigned v) { return __hip_atomic_fetch_add(p, v, __ATOMIC_RELAXED, __HIP_MEMORY_SCOPE_AGENT); }
DEV unsigned xb_xcc_id() { return (unsigned)__builtin_amdgcn_s_getreg((3 << 11) | 20) & 0xFu; }
#define XB_SPIN(cond, bar) do { unsigned _sp = 0; while (cond) { __builtin_amdgcn_s_sleep(1); \
    if ((++_sp & 255u) == 0u) { if (xb_ld(&(bar)[XB_TMO])) break; if (_sp > XB_SPIN_CAP) { atomicAdd(&(bar)[XB_TMO], 1u); break; } } } } while (0)
struct XcdBarrier { unsigned* bar; unsigned x; volatile LAS unsigned* st; };
DEV XcdBarrier xcd_barrier_post(unsigned* bar, volatile LAS unsigned* st) {
    XcdBarrier b; b.bar = bar; b.x = xb_xcc_id(); b.st = st;
    if (threadIdx.x == 0) (void)xb_add(&bar[XB_XCNT(b.x)], 1u);
    return b;
}
DEV void xcd_barrier_complete(unsigned* bar, unsigned x, unsigned& nloc, unsigned& nx) {
    const unsigned G = gridDim.x * gridDim.y * gridDim.z;
    unsigned sum, cnt, mine, sp = 0u;
    for (;;) {
        sum = 0u; cnt = 0u; mine = 0u;
#pragma unroll
        for (unsigned j = 0; j < 16; ++j) { const unsigned c = xb_ld(&bar[XB_XCNT(j)]); sum += c; cnt += (c > 0u) ? 1u : 0u; mine = (j == x) ? c : mine; }
        if (sum == G) break;
        __builtin_amdgcn_s_sleep(1);
        if ((++sp & 255u) == 0u) { if (xb_ld(&bar[XB_TMO])) break; if (sp > XB_SPIN_CAP) { atomicAdd(&bar[XB_TMO], 1u); break; } }
    }
    nloc = mine > 0u ? mine : 1u; nx = cnt > 0u ? cnt : 1u;
}
DEV void xcd_barrier(const XcdBarrier& b) {
    asm volatile("s_waitcnt vmcnt(0)" ::: "memory");
    __syncthreads();
    if (threadIdx.x == 0) {
        unsigned* bar = b.bar;
        __builtin_amdgcn_s_waitcnt(0);
        unsigned nloc = b.st[0], nx = b.st[1];
        if (nloc == 0u) { xcd_barrier_complete(bar, b.x, nloc, nx); b.st[0] = nloc; b.st[1] = nx; }
        const unsigned old = xb_add(&bar[XB_XSUB(b.x)], 1u);
        const unsigned gen = old / nloc;
        if (old + 1u == (gen + 1u) * nloc) {
            __builtin_amdgcn_fence(__ATOMIC_RELEASE, "agent");
            asm volatile("s_waitcnt vmcnt(0)" ::: "memory");
            const unsigned og = xb_add(&bar[XB_TOP], 1u);
            const unsigned tg = og / nx;
            if (og + 1u == (tg + 1u) * nx) xb_add(&bar[XB_TOPGEN], 1u);
            else XB_SPIN(xb_ld(&bar[XB_TOPGEN]) == tg, bar);
            __builtin_amdgcn_fence(__ATOMIC_ACQUIRE, "agent");
            xb_add(&bar[XB_XGEN(b.x)], 1u);
            asm volatile("s_waitcnt vmcnt(0)" ::: "memory");
        } else {
            XB_SPIN(xb_ld(&bar[XB_XGEN(b.x)]) == gen, bar);
            __builtin_amdgcn_fence(__ATOMIC_ACQUIRE, "agent");
            asm volatile("s_waitcnt vmcnt(0)" ::: "memory");
        }
    }
    __syncthreads();
}

namespace g8 {
constexpr int BM = 256, BK = 64, HALF = 128, HTB = HALF * BK * 2, STAGE_BYTES = 8 * HTB;
DEV int lds_byte(int r, int c) { const int st = (r >> 4) * 2 + (c >> 5), rr = r & 15, cc = c & 31, ob = rr * 64 + cc * 2; return st * 1024 + (ob ^ (((ob >> 9) & 1) << 5)); }
DEV void stage_rc(int b, int& R, int& C) { const int st = b / 1024, sb = b % 1024, swz = sb ^ (((sb >> 9) & 1) << 5); R = (st >> 1) * 16 + swz / 64; C = (st & 1) * 32 + (swz % 64) / 2; }

struct UCtx {
    const char* A; const char* B0; const char* B1;
    unsigned aoff[2][2];
    int i0, i1, i2, i3, i4;
    int swap;
};

template <class Job>
DEV void gemm_phase(LAS unsigned char* lds, const Job& J) {
    const int tid = tid_(), wid = __builtin_amdgcn_readfirstlane(tid >> 6), lane = tid & 63, wr = wid >> 2, wc = wid & 3, fr = lane & 15, fq = lane >> 4;
    constexpr int ESZ = Job::FP8 ? 1 : 2;
    constexpr int K = Job::K, nt = K * ESZ / 128, KSPLIT = Job::KSPLIT, LDB = Job::LDB;
    int Rr[2], Cc[2]; unsigned voffB[2];
#pragma unroll
    for (int i = 0; i < 2; ++i) { int R, C; stage_rc(tid * 16 + i * 8192, R, C); Rr[i] = R; Cc[i] = C; voffB[i] = (unsigned)(R * LDB * ESZ + C * 2); }
    constexpr size_t kstep = (size_t)(BK * 2);
    constexpr size_t hstepB = (size_t)HALF * LDB * ESZ;
    const unsigned ldsw = (unsigned)wid * 1024u;
    const int aoff = lds_byte(wr * 64 + fr, fq * 8), boff = lds_byte(wc * 32 + fr, fq * 8);
#define G8_SA(b, h) (((b) * 2 + (h)) * HTB)
#define G8_SB(b, h) ((4 + (b) * 2 + (h)) * HTB)
#define G8_STAGE_A(bufoff, cx, h, tb) do { _Pragma("unroll") for (int _i = 0; _i < 2; ++_i) \
        __builtin_amdgcn_raw_ptr_buffer_load_lds(rsrcA, (LAS unsigned*)(lds + (bufoff) + ldsw + _i * 8192), 16, (int)(cx).aoff[h][_i], (int)(tb), 0, 0); } while (0)
#define G8_STAGE_B(bufoff, bp, h) do { _Pragma("unroll") for (int _i = 0; _i < 2; ++_i) \
        __builtin_amdgcn_raw_ptr_buffer_load_lds(rsrcB, (LAS unsigned*)(lds + (bufoff) + ldsw + _i * 8192), 16, (int)voffB[_i], (int)((unsigned)((bp) - bbase) + (unsigned)((h) * hstepB)), 0, 0); } while (0)
#define G8_BT(cx, t) (((t) < KSPLIT) ? (cx).B0 + (size_t)(t) * kstep : (cx).B1 + (size_t)((t) - KSPLIT) * kstep)
#define G8_LDA(dst, b, h) do { if constexpr (Job::FP8) { _Pragma("unroll") for (int m = 0; m < 4; ++m) { const i32x4 lo_ = *(const LAS i32x4*)(lds + G8_SA(b, h) + aoff + m * 2048), hi_ = *(const LAS i32x4*)(lds + G8_SA(b, h) + aoff + m * 2048 + 1024); \
            dst##8[m] = __builtin_shufflevector(lo_, hi_, 0, 1, 2, 3, 4, 5, 6, 7); } } \
        else { _Pragma("unroll") for (int m = 0; m < 4; ++m) _Pragma("unroll") for (int k = 0; k < 2; ++k) dst[m][k] = *(const LAS bf16x8*)(lds + G8_SA(b, h) + aoff + m * 2048 + k * 1024); } } while (0)
#define G8_LDB(dst, b, h) do { if constexpr (Job::FP8) { _Pragma("unroll") for (int n = 0; n < 2; ++n) { const i32x4 lo_ = *(const LAS i32x4*)(lds + G8_SB(b, h) + boff + n * 2048), hi_ = *(const LAS i32x4*)(lds + G8_SB(b, h) + boff + n * 2048 + 1024); \
            dst##8[n] = __builtin_shufflevector(lo_, hi_, 0, 1, 2, 3, 4, 5, 6, 7); } } \
        else { _Pragma("unroll") for (int n = 0; n < 2; ++n) _Pragma("unroll") for (int k = 0; k < 2; ++k) dst[n][k] = *(const LAS bf16x8*)(lds + G8_SB(b, h) + boff + n * 2048 + k * 1024); } } while (0)
#define G8_MMA(ai, bj, At, Bt) do { __builtin_amdgcn_s_setprio(1); \
        if constexpr (Job::FP8) { _Pragma("unroll") for (int m = 0; m < 4; ++m) _Pragma("unroll") for (int n = 0; n < 2; ++n) \
            { if constexpr (Job::SWAPPED) asm volatile("v_mfma_f32_16x16x128_f8f6f4 %0, %1, %2, %0" : "+v"(acc[ai][bj][m][n]) : "v"(At##8[m]), "v"(Bt##8[n])); \
              else asm volatile("v_mfma_f32_16x16x128_f8f6f4 %0, %1, %2, %0" : "+v"(acc[ai][bj][m][n]) : "v"(Bt##8[n]), "v"(At##8[m])); } } \
        else if constexpr (Job::SWAPPED) { _Pragma("unroll") for (int m = 0; m < 4; ++m) _Pragma("unroll") for (int n = 0; n < 2; ++n) _Pragma("unroll") for (int k = 0; k < 2; ++k) \
            acc[ai][bj][m][n] = __builtin_amdgcn_mfma_f32_16x16x32_bf16(At[m][k], Bt[n][k], acc[ai][bj][m][n], 0, 0, 0); } \
        else { _Pragma("unroll") for (int m = 0; m < 4; ++m) _Pragma("unroll") for (int n = 0; n < 2; ++n) _Pragma("unroll") for (int k = 0; k < 2; ++k) \
            acc[ai][bj][m][n] = __builtin_amdgcn_mfma_f32_16x16x32_bf16(Bt[n][k], At[m][k], acc[ai][bj][m][n], 0, 0, 0); } \
        __builtin_amdgcn_s_setprio(0); } while (0)
#define G8_WAIT_V(n) asm volatile("s_waitcnt vmcnt(" #n ")" ::: "memory")
#define G8_WAIT_L(n) asm volatile("s_waitcnt lgkmcnt(" #n ")" ::: "memory")
#define G8_BAR __builtin_amdgcn_s_barrier()
#define G8_SCHED __builtin_amdgcn_sched_barrier(0)
    UCtx cur, nxt; int ui = 0; unsigned* pend = nullptr;
    if (!J.get(0, cur, Rr, Cc)) return;
#define G8_DEPWAIT(cx) do { if constexpr (Job::SYNC == 2) { if (tid == 0) { unsigned* tc_ = J.tile_counter(cx); unsigned sp_ = 0; while (xb_ld(tc_) < 8u && ++sp_ < XB_SPIN_CAP) __builtin_amdgcn_s_sleep(2); \
            __builtin_amdgcn_fence(__ATOMIC_ACQUIRE, "agent"); } __syncthreads(); } } while (0)
    G8_DEPWAIT(cur);
    const char* const bbase = J.bbase();
    const __amdgpu_buffer_rsrc_t rsrcA = __builtin_amdgcn_make_buffer_rsrc((void*)cur.A, 0, 0x7fffffff, 0x00020000);
    const __amdgpu_buffer_rsrc_t rsrcB = __builtin_amdgcn_make_buffer_rsrc((void*)bbase, 0, 0x7fffffff, 0x00020000);
    f32x4 acc[2][2][4][2];
#pragma unroll
    for (int a = 0; a < 2; ++a)
#pragma unroll
        for (int b = 0; b < 2; ++b)
#pragma unroll
            for (int m = 0; m < 4; ++m)
#pragma unroll
                for (int n = 0; n < 2; ++n) acc[a][b][m][n] = (f32x4){0.f, 0.f, 0.f, 0.f};
    bf16x8 At[4][2], B0[2][2], B1[2][2];
    i32x8 At8[4], B08[2], B18[2];
    { const char* b0 = G8_BT(cur, 0); const char* b1 = G8_BT(cur, 1);
      G8_STAGE_B(G8_SB(0, 0), b0, 0); G8_STAGE_B(G8_SB(0, 1), b0, 1); G8_STAGE_A(G8_SA(0, 0), cur, 0, 0); G8_STAGE_A(G8_SA(0, 1), cur, 1, 0);
      if (wr == 1) G8_BAR;
      G8_WAIT_V(2); G8_BAR;
      G8_STAGE_B(G8_SB(1, 0), b1, 0); G8_STAGE_A(G8_SA(1, 0), cur, 0, kstep); G8_STAGE_B(G8_SB(1, 1), b1, 1);
      G8_WAIT_V(6); G8_BAR; }
    for (;;) {
        const bool has_next = J.get(ui + 1, nxt, Rr, Cc);
        if (has_next) G8_DEPWAIT(nxt);
        if (!has_next) { nxt.A = cur.A; nxt.B0 = cur.B0; nxt.B1 = cur.B1; nxt.aoff[0][0] = cur.aoff[0][0]; nxt.aoff[0][1] = cur.aoff[0][1]; nxt.aoff[1][0] = cur.aoff[1][0]; nxt.aoff[1][1] = cur.aoff[1][1]; }
        for (int t = 0; t < nt; t += 2) {
            const bool last = (t == nt - 2);
            const int t2 = last ? 0 : t + 2, t3 = last ? 1 : t + 3;
            const char* b2 = last ? G8_BT(nxt, t2) : G8_BT(cur, t2); const char* b3 = last ? G8_BT(nxt, t3) : G8_BT(cur, t3);
            struct { const char* A; unsigned aoff[2][2]; } c2;
            c2.A = last ? nxt.A : cur.A;
            c2.aoff[0][0] = last ? nxt.aoff[0][0] : cur.aoff[0][0]; c2.aoff[0][1] = last ? nxt.aoff[0][1] : cur.aoff[0][1];
            c2.aoff[1][0] = last ? nxt.aoff[1][0] : cur.aoff[1][0]; c2.aoff[1][1] = last ? nxt.aoff[1][1] : cur.aoff[1][1];
            const size_t a1b = (size_t)(t + 1) * kstep, a2b = (size_t)t2 * kstep, a3b = (size_t)t3 * kstep;
            G8_LDB(B0, 0, 0); G8_LDB(B1, 0, 1); G8_SCHED; G8_LDA(At, 0, 0); G8_STAGE_A(G8_SA(1, 1), cur, 1, a1b);
            G8_WAIT_V(8); G8_WAIT_L(0); G8_BAR; G8_MMA(0, 0, At, B0); G8_MMA(0, 1, At, B1); G8_BAR; G8_SCHED;
            G8_LDA(At, 0, 1); G8_STAGE_B(G8_SB(0, 0), b2, 0); G8_STAGE_B(G8_SB(0, 1), b2, 1); G8_STAGE_A(G8_SA(0, 0), c2, 0, a2b);
            G8_WAIT_V(8); G8_WAIT_L(0); G8_BAR; G8_MMA(1, 0, At, B0); G8_MMA(1, 1, At, B1); G8_BAR; G8_SCHED;
            G8_LDB(B0, 1, 0); G8_LDB(B1, 1, 1); G8_SCHED; G8_LDA(At, 1, 0); G8_STAGE_A(G8_SA(0, 1), c2, 1, a2b);
            G8_WAIT_V(8); G8_WAIT_L(0); G8_BAR; G8_MMA(0, 0, At, B0); G8_MMA(0, 1, At, B1); G8_BAR; G8_SCHED;
            G8_LDA(At, 1, 1); G8_STAGE_B(G8_SB(1, 0), b3, 0); G8_STAGE_B(G8_SB(1, 1), b3, 1); G8_STAGE_A(G8_SA(1, 0), c2, 0, a3b);
            G8_WAIT_V(8); G8_WAIT_L(0); G8_BAR; G8_MMA(1, 0, At, B0); G8_MMA(1, 1, At, B1); G8_BAR; G8_SCHED;
        }
        if (wr == 0) G8_BAR;
        if constexpr (Job::FP8) asm volatile("s_nop 15\n\ts_nop 7" ::: "memory");
        if constexpr (Job::SYNC == 1) {
            if (pend != nullptr && tid == 0) (void)xb_add(pend, 1u);
        }
        J.epi(acc, cur, wr, wc, fr, fq);
        if constexpr (Job::SYNC == 1) {
            if (has_next) pend = J.tile_counter(cur);
            else { asm volatile("s_waitcnt vmcnt(0)" ::: "memory"); __syncthreads(); if (tid == 0) (void)xb_add(J.tile_counter(cur), 1u); }
        }
        if (!has_next) break;
#pragma unroll
        for (int a = 0; a < 2; ++a)
#pragma unroll
            for (int b = 0; b < 2; ++b)
#pragma unroll
                for (int m = 0; m < 4; ++m)
#pragma unroll
                    for (int n = 0; n < 2; ++n) acc[a][b][m][n] = (f32x4){0.f, 0.f, 0.f, 0.f};
        cur.A = nxt.A; cur.B0 = nxt.B0; cur.B1 = nxt.B1; cur.aoff[0][0] = nxt.aoff[0][0]; cur.aoff[0][1] = nxt.aoff[0][1]; cur.aoff[1][0] = nxt.aoff[1][0]; cur.aoff[1][1] = nxt.aoff[1][1];
        cur.i0 = nxt.i0; cur.i1 = nxt.i1; cur.i2 = nxt.i2; cur.i3 = nxt.i3; cur.i4 = nxt.i4; cur.swap = nxt.swap; ++ui;
        if (wr == 1) G8_BAR;
    }
    G8_WAIT_V(0);
    G8_BAR;
#undef G8_DEPWAIT
#undef G8_SA
#undef G8_SB
#undef G8_STAGE_A
#undef G8_STAGE_B
#undef G8_BT
#undef G8_LDA
#undef G8_LDB
#undef G8_MMA
#undef G8_WAIT_V
#undef G8_WAIT_L
#undef G8_BAR
#undef G8_SCHED
}
}
using g8::UCtx;

DEV bool deal(int i, int nPanels, int nN, int& pm, int& pn, bool rev = false) {
    const int G = (int)gridDim.x, bid = (int)blockIdx.x;
    if ((G & 7) == 0) {
        const int x = bid & 7, W = G >> 3, w = rev ? W - 1 - (bid >> 3) : (bid >> 3);
        const int v = w + W * i, j = v / nN; pn = v - j * nN; pm = x + 8 * j;
        return pm < nPanels;
    } else {
        const int v = (rev ? G - 1 - bid : bid) + G * i; pm = v / nN; pn = v - pm * nN; return pm < nPanels;
    }
}

constexpr int CTX_D0 = 32;
template <bool VT, bool F8>
struct JobInProj {
    static constexpr int K = 1024, LDB = 1024, KSPLIT = F8 ? 8 : 16, SWAPPED = VT ? 1 : 0, FP8 = F8 ? 1 : 0; static constexpr int SYNC = 0;
    P p; int mode;
    DEV const char* bbase() const { return (const char*)(p.ws + WS_WIN) + (F8 ? 0 : 2 * MB_); }
    DEV bool get(int i, UCtx& c, const int (&Rr)[2], const int (&Cc)[2]) const {
        const int G = (int)gridDim.x, bid = (int)blockIdx.x; int pm, pn;
        const int x = bid & 7, W = G >> 3;
        if (mode == 2) { if (i) return false; pm = 128 + x; pn = 2 + ((bid - CTX_D0) >> 3); }
        else if constexpr (!VT && F8) {
            const int w = bid >> 3, v = w + W * i;
            if (v < 64) { pm = x + 8 * (v >> 2); pn = v & 3; }
            else if (v < 66 && mode == 0) { pm = 128 + x; pn = 2 + (v - 64); }
            else return false;
        } else if constexpr (VT) {
            const int w = W - 1 - (bid >> 3), v = w + W * i;
            if (v < 32) { pm = x + 8 * (v >> 1); pn = 4 + (v & 1); }
            else if (v < 34 && mode == 0) { pm = 128 + x; pn = 4 + (v - 32); }
            else return false;
        } else {
            const int w = ((bid >> 3) + (W >> 1)) % W, v = w + W * i;
            if (v < 64) { pm = x + 8 * (v >> 2); pn = 6 + (v & 3); }
            else if (v < 66 && mode == 0) { pm = 128 + x; pn = 6 + (v - 64); }
            else return false;
        }
        if constexpr (F8) { c.A = (const char*)p.out; c.B0 = (const char*)(p.ws + WS_WIN) + (size_t)(256 * pn) * LDB; }
        else { c.A = (const char*)(p.ws + WS_H); c.B0 = (const char*)(p.ws + WS_WIN) + 2 * MB_ + (size_t)(256 * (pn - 6)) * LDB * 2; }
        c.B1 = c.B0;
#pragma unroll
        for (int h = 0; h < 2; ++h)
#pragma unroll
            for (int k = 0; k < 2; ++k) c.aoff[h][k] = F8 ? (unsigned)((256 * pm + 128 * h + Rr[k]) * K + Cc[k] * 2) : (unsigned)((256 * pm + 128 * h + Rr[k]) * K + Cc[k]) * 2u;
        c.i0 = pm; c.i1 = pn; c.i2 = 0; c.i3 = 0; c.i4 = 0; c.swap = (pn == 4 || pn == 5) ? 1 : 0;
        return true;
    }
    DEV void epi(const f32x4 (&acc)[2][2][4][2], const UCtx& c, int wr, int wc, int fr, int fq) const {
        constexpr float ISC = F8 ? 1.0f / (F8_SH * F8_SW) : 1.0f;
        const int pm = c.i0, pn = c.i1; const bool isctx = pm >= 128;
        unsigned char* R = p.ws + WS_R;
        const int rowbase = isctx ? (256 * pm - MTOK) : 256 * pm;
        if constexpr (!VT) { if constexpr (F8) {
            const bool isq = pn < 2; const int head = 4 * (pn & 1) + wc;
            const float* gn = isq ? p.qn : p.kn; const float osc = isq ? 0.125f * LOG2E : 1.0f;
            f32x4 g[2][2];
#pragma unroll
            for (int bj = 0; bj < 2; ++bj)
#pragma unroll
                for (int n = 0; n < 2; ++n) g[bj][n] = *(const f32x4*)(gn + 32 * bj + 8 * fq + 4 * n);
            bf16_t* dst = (bf16_t*)(R + (isq ? R_Q : (isctx ? R_KC : R_K)));
#pragma unroll
            for (int ai = 0; ai < 2; ++ai)
#pragma unroll
                for (int m = 0; m < 4; ++m) {
                    float ss = 0.f;
#pragma unroll
                    for (int bj = 0; bj < 2; ++bj)
#pragma unroll
                        for (int n = 0; n < 2; ++n) { const f32x4 v = acc[ai][bj][m][n]; ss += v[0] * v[0] + v[1] * v[1] + v[2] * v[2] + v[3] * v[3]; }
                    ss += __shfl_xor(ss, 16); ss += __shfl_xor(ss, 32);
                    const float rs = rsqrtf(ss * (ISC * ISC / 64.0f) + 1e-6f) * osc * ISC;
                    const int row = rowbase + 128 * ai + 64 * wr + 16 * m + fr;
#pragma unroll
                    for (int bj = 0; bj < 2; ++bj) {
                        const f32x4 v0 = acc[ai][bj][m][0] * rs * g[bj][0], v1 = acc[ai][bj][m][1] * rs * g[bj][1];
                        u32x4 w; w.x = pk_bf16(v0[0], v0[1]); w.y = pk_bf16(v0[2], v0[3]); w.z = pk_bf16(v1[0], v1[1]); w.w = pk_bf16(v1[2], v1[3]);
                        *(u32x4*)(dst + (size_t)row * 512 + head * 64 + 32 * bj + 8 * fq) = w;
                    }
                }
        } else {
            const bool gel = pn >= 8; const int colbase = 256 * ((pn - 6) & 1) + 64 * wc;
            bf16_t* dst = (bf16_t*)(R + (gel ? R_GB : (isctx ? R_XBC : R_XB)));
#pragma unroll
            for (int ai = 0; ai < 2; ++ai)
#pragma unroll
                for (int m = 0; m < 4; ++m) {
                    const int row = rowbase + 128 * ai + 64 * wr + 16 * m + fr;
#pragma unroll
                    for (int bj = 0; bj < 2; ++bj) {
                        f32x4 v0 = acc[ai][bj][m][0], v1 = acc[ai][bj][m][1];
                        if (gel) {
#pragma unroll
                            for (int q = 0; q < 4; ++q) { v0[q] = gelu_tanh(v0[q]); v1[q] = gelu_tanh(v1[q]); }
                        }
                        u32x4 w; w.x = pk_bf16(v0[0], v0[1]); w.y = pk_bf16(v0[2], v0[3]); w.z = pk_bf16(v1[0], v1[1]); w.w = pk_bf16(v1[2], v1[3]);
                        *(u32x4*)(dst + (size_t)row * 512 + colbase + 32 * bj + 8 * fq) = w;
                    }
                }
        } } else {
            const int head = 4 * (pn - 4) + wc;
            bf16_t* dst = (bf16_t*)(R + (isctx ? R_VCT : R_VT));
            const int tshift = isctx ? 8 : 12, tlen = isctx ? CTXL : SEQ;
#pragma unroll
            for (int ai = 0; ai < 2; ++ai)
#pragma unroll
                for (int m = 0; m < 4; ++m) {
                    const int tok = rowbase + 128 * ai + 64 * wr + 16 * m + 4 * fq;
                    const int b = tok >> tshift, nn = tok & (tlen - 1);
#pragma unroll
                    for (int bj = 0; bj < 2; ++bj)
#pragma unroll
                        for (int n = 0; n < 2; ++n) {
                            const int d = 32 * bj + 8 * (fr >> 2) + 4 * n + (fr & 3);
                            const f32x4 v = acc[ai][bj][m][n] * ISC;
                            u32x2 w; w.x = pk_bf16(v[0], v[1]); w.y = pk_bf16(v[2], v[3]);
                            *(u32x2*)(dst + ((size_t)((b * 8 + head) * 64 + d)) * tlen + nn) = w;
                        }
                }
        }
    }
};

template <int KK, bool BASE_BF16>
struct JobResid {
    static constexpr int K = KK, LDB = KK, KSPLIT = KK / 64, SWAPPED = 0, FP8 = 0; static constexpr int SYNC = 0;
    const bf16_t* A; const bf16_t* Bt; const void* base; bf16_t* out; const float* gate;
    DEV const char* bbase() const { return (const char*)Bt; }
    DEV bool get(int i, UCtx& c, const int (&Rr)[2], const int (&Cc)[2]) const {
        int pm, pn; if (!deal(i, 128, 4, pm, pn)) return false;
        c.A = (const char*)A; c.B0 = (const char*)Bt + (size_t)(256 * pn) * LDB * 2; c.B1 = c.B0;
#pragma unroll
        for (int h = 0; h < 2; ++h)
#pragma unroll
            for (int k = 0; k < 2; ++k) c.aoff[h][k] = (unsigned)((256 * pm + 128 * h + Rr[k]) * K + Cc[k]) * 2u;
        c.i0 = pm; c.i1 = pn; c.i2 = 0; c.i3 = 0; c.i4 = 0; c.swap = 0; return true;
    }
    DEV void epi(const f32x4 (&acc)[2][2][4][2], const UCtx& c, int wr, int wc, int fr, int fq) const {
        const int pm = c.i0, pn = c.i1; const int b = pm >> 4;
        const int col0 = 256 * pn + 32 * wc + 8 * fq;
        f32x4 gv[2][2];
#pragma unroll
        for (int bj = 0; bj < 2; ++bj)
#pragma unroll
            for (int n = 0; n < 2; ++n) gv[bj][n] = *(const f32x4*)(gate + (size_t)b * 6144 + col0 + 128 * bj + 4 * n);
#pragma unroll
        for (int ai = 0; ai < 2; ++ai)
#pragma unroll
        for (int mp = 0; mp < 2; ++mp) {
            f32x4 bs[2][2][2];
#pragma unroll
            for (int mm = 0; mm < 2; ++mm) { const size_t off = (size_t)(256 * pm + 128 * ai + 64 * wr + 16 * (2 * mp + mm) + fr) * DM + col0;
#pragma unroll
                for (int bj = 0; bj < 2; ++bj) {
                    if constexpr (BASE_BF16) { const u32x4 w = *(const u32x4*)((const bf16_t*)base + off + 128 * bj); bs[mm][bj][0] = (f32x4){bflo(w.x), bfhi(w.x), bflo(w.y), bfhi(w.y)}; bs[mm][bj][1] = (f32x4){bflo(w.z), bfhi(w.z), bflo(w.w), bfhi(w.w)}; }
                    else { bs[mm][bj][0] = *(const f32x4*)((const float*)base + off + 128 * bj); bs[mm][bj][1] = *(const f32x4*)((const float*)base + off + 128 * bj + 4); } } }
#pragma unroll
            for (int mm = 0; mm < 2; ++mm) { const int m = 2 * mp + mm; const size_t off = (size_t)(256 * pm + 128 * ai + 64 * wr + 16 * m + fr) * DM + col0;
#pragma unroll
                for (int bj = 0; bj < 2; ++bj) { const f32x4 v0 = bs[mm][bj][0] + gv[bj][0] * acc[ai][bj][m][0], v1 = bs[mm][bj][1] + gv[bj][1] * acc[ai][bj][m][1];
                    u32x4 w; w.x = pk_bf16(v0[0], v0[1]); w.y = pk_bf16(v0[2], v0[3]); w.z = pk_bf16(v1[0], v1[1]); w.w = pk_bf16(v1[2], v1[3]); *(u32x4*)(out + off + 128 * bj) = w; } }
        }
    }
};

template <int PART>
struct JobHerm {
    static constexpr int K = 1024, LDB = 2048, KSPLIT = 8, SWAPPED = 0, FP8 = 1; static constexpr int SYNC = 0;
    P p; bf16_t* xa;
    DEV const char* bbase() const { return (const char*)(p.ws + WS_WFOLD); }
    DEV bool get(int i, UCtx& c, const int (&Rr)[2], const int (&Cc)[2]) const {
        int pm, pn; if (!deal(i, 64, 4, pm, pn)) return false;
        c.A = (const char*)(p.ws + WS_R + R_Y) + PART * 1024; c.B0 = (const char*)(p.ws + WS_WFOLD) + ((size_t)(256 * pn) * LDB + PART * 1024); c.B1 = c.B0;
#pragma unroll
        for (int h = 0; h < 2; ++h)
#pragma unroll
            for (int k = 0; k < 2; ++k) c.aoff[h][k] = (unsigned)((256 * pm + 128 * h + Rr[k]) * 2048 + Cc[k] * 2);
        c.i0 = pm; c.i1 = pn; c.i2 = 0; c.i3 = 0; c.i4 = 0; c.swap = 0; return true;
    }
    DEV void epi(const f32x4 (&acc)[2][2][4][2], const UCtx& c, int wr, int wc, int fr, int fq) const {
        constexpr float ISC = 1.0f / (F8_SY * F8_SWF);
        const int pm = c.i0, pn = c.i1; const int b = pm >> 3;
        const int col0 = 256 * pn + 32 * wc + 8 * fq;
        bf16_t* Pb = (bf16_t*)(p.ws + WS_R + R_P);
        if constexpr (PART == 0) {
#pragma unroll
            for (int ai = 0; ai < 2; ++ai)
#pragma unroll
                for (int m = 0; m < 4; ++m) { const size_t off = (size_t)(256 * pm + 128 * ai + 64 * wr + 16 * m + fr) * DM + col0;
#pragma unroll
                    for (int bj = 0; bj < 2; ++bj) { const f32x4 v0 = acc[ai][bj][m][0] * ISC, v1 = acc[ai][bj][m][1] * ISC;
                        u32x4 w; w.x = pk_bf16(v0[0], v0[1]); w.y = pk_bf16(v0[2], v0[3]); w.z = pk_bf16(v1[0], v1[1]); w.w = pk_bf16(v1[2], v1[3]); *(u32x4*)(Pb + off + 128 * bj) = w; } }
        } else {
            const float* gate = (const float*)(p.ws + WS_MOD) + (size_t)9 * 6144 + 2048 + (size_t)b * 6144 + col0;
            f32x4 gv[2][2];
#pragma unroll
            for (int bj = 0; bj < 2; ++bj)
#pragma unroll
                for (int n = 0; n < 2; ++n) gv[bj][n] = *(const f32x4*)(gate + 128 * bj + 4 * n);
#pragma unroll
            for (int ai = 0; ai < 2; ++ai)
#pragma unroll
                for (int m = 0; m < 4; ++m) {
                    const int prow = 256 * pm + 128 * ai + 64 * wr + 16 * m + fr, kk = prow & 2047;
                    const size_t poff = (size_t)prow * DM + col0;
                    const size_t o1 = ((size_t)b * SEQ + kk) * DM + col0, o2 = ((size_t)b * SEQ + ((SEQ - kk) & (SEQ - 1))) * DM + col0;
                    u32x4 pw[2], x1[2], x2[2];
#pragma unroll
                    for (int bj = 0; bj < 2; ++bj) { pw[bj] = *(const u32x4*)(Pb + poff + 128 * bj); x1[bj] = *(const u32x4*)(xa + o1 + 128 * bj); x2[bj] = *(const u32x4*)(xa + o2 + 128 * bj); }
#pragma unroll
                    for (int bj = 0; bj < 2; ++bj) {
                        const unsigned pwv[4] = {pw[bj].x, pw[bj].y, pw[bj].z, pw[bj].w}, x1v[4] = {x1[bj].x, x1[bj].y, x1[bj].z, x1[bj].w}, x2v[4] = {x2[bj].x, x2[bj].y, x2[bj].z, x2[bj].w};
                        unsigned r1[4], r2[4];
#pragma unroll
                        for (int q = 0; q < 4; ++q) {
                            const float g0 = gv[bj][q >> 1][2 * (q & 1)], g1 = gv[bj][q >> 1][2 * (q & 1) + 1];
                            const float q0 = acc[ai][bj][m][q >> 1][2 * (q & 1)] * ISC, q1 = acc[ai][bj][m][q >> 1][2 * (q & 1) + 1] * ISC;
                            const float p0 = bflo(pwv[q]), p1 = bfhi(pwv[q]);
                            r1[q] = pk_bf16(bflo(x1v[q]) + g0 * (p0 + q0), bfhi(x1v[q]) + g1 * (p1 + q1));
                            r2[q] = pk_bf16(bflo(x2v[q]) + g0 * (p0 - q0), bfhi(x2v[q]) + g1 * (p1 - q1));
                        }
                        *(u32x4*)(xa + o1 + 128 * bj) = (u32x4){r1[0], r1[1], r1[2], r1[3]};
                        if (kk != 0) *(u32x4*)(xa + o2 + 128 * bj) = (u32x4){r2[0], r2[1], r2[2], r2[3]};
                    }
                }
        }
    }
};
DEV void phase_herm_row2048(const P& p, LAS unsigned char* lds, bf16_t* xa) {
    const int tid = tid_();
    for (int bid = (int)blockIdx.x; bid < 256; bid += (int)gridDim.x) {
    const int b = bid >> 5, o = 32 * (bid & 31) + (tid & 31), kq = tid >> 5;
    const float* y = (const float*)(p.ws + WS_Y2048) + b * 1024 + 64 * kq;
    const unsigned char* w = p.ws + WS_WFOLD + (size_t)l8row(o) * 2048 + 64 * kq;
    u32x2 wq[8]; f32x4 yq[8][2];
#pragma unroll
    for (int q = 0; q < 8; ++q) { wq[q] = *(const u32x2*)(w + 8 * q); yq[q][0] = *(const f32x4*)(y + 8 * q); yq[q][1] = *(const f32x4*)(y + 8 * q + 4); }
    __builtin_amdgcn_sched_barrier(0);
    float a = 0.f;
#pragma unroll
    for (int q = 0; q < 8; ++q) { const u32x2 ww = wq[q]; const f32x4 y0 = yq[q][0], y1 = yq[q][1];
        const f32v2_ w01 = __builtin_amdgcn_cvt_pk_f32_fp8((int)ww.x, false), w23 = __builtin_amdgcn_cvt_pk_f32_fp8((int)ww.x, true), w45 = __builtin_amdgcn_cvt_pk_f32_fp8((int)ww.y, false), w67 = __builtin_amdgcn_cvt_pk_f32_fp8((int)ww.y, true);
        a += y0[0] * w01[0] + y0[1] * w01[1] + y0[2] * w23[0] + y0[3] * w23[1] + y1[0] * w45[0] + y1[1] * w45[1] + y1[2] * w67[0] + y1[3] * w67[1]; }
    a *= (1.0f / F8_SWF);
    LAS float* red = (LAS float*)lds;
    red[tid] = a; __syncthreads();
    if (tid < 32) { float tot = 0.f;
#pragma unroll
        for (int q = 0; q < 16; ++q) tot += red[tid + 32 * q];
        const float g = ((const float*)(p.ws + WS_MOD))[(size_t)9 * 6144 + (size_t)b * 6144 + 2048 + o];
        bf16_t* x = xa + ((size_t)b * SEQ + 2048) * DM + o; *x = f2bf(bf2f(*x) + g * tot); }
    __syncthreads();
    }
}

struct JobFold {
    static constexpr int K = 256, LDB = 256, KSPLIT = 4, SWAPPED = 0, FP8 = 0; static constexpr int SYNC = 0;
    P p;
    DEV const char* bbase() const { return (const char*)(p.ws + WS_CS); }
    DEV bool get(int i, UCtx& c, const int (&Rr)[2], const int (&Cc)[2]) const {
        const int u = (int)blockIdx.x; if (i != 0 || u >= 32) return false;
        const int g = u >> 3, pm = (u >> 1) & 3, pn = u & 1;
        c.A = (const char*)(p.ws + WS_WF); c.B0 = (const char*)(p.ws + WS_CS) + (size_t)(256 * pn) * LDB * 2; c.B1 = c.B0;
#pragma unroll
        for (int h = 0; h < 2; ++h)
#pragma unroll
            for (int k = 0; k < 2; ++k) c.aoff[h][k] = (unsigned)((256 * pm + 128 * h + Rr[k]) * 1024 + g * 256 + Cc[k]) * 2u;
        c.i0 = pm; c.i1 = pn; c.i2 = g; c.i3 = 0; c.i4 = 0; c.swap = 0; return true;
    }
    DEV void epi(const f32x4 (&acc)[2][2][4][2], const UCtx& c, int wr, int wc, int fr, int fq) const {
        unsigned char* W = p.ws + WS_WFOLD;
        const int pm = c.i0, pn = c.i1, g = c.i2;
#pragma unroll
        for (int ai = 0; ai < 2; ++ai)
#pragma unroll
            for (int m = 0; m < 4; ++m) {
                const int o = l8row(256 * pm + 128 * ai + 64 * wr + 16 * m + fr);
#pragma unroll
                for (int bj = 0; bj < 2; ++bj)
#pragma unroll
                    for (int n = 0; n < 2; ++n) {
                        const f32x4 v = acc[ai][bj][m][n] * (F8_SWF / 1024.0f);
                        *(unsigned*)(W + (size_t)o * 2048 + pn * 1024 + g * 256 + 128 * bj + 32 * wc + 16 * n + 4 * fq) = pk4_fp8(v[0], v[1], v[2], v[3]);
                    }
            }
    }
};

struct MoeTab { int tstart[NPAIR + 1]; int sbase[NPAIR + 1]; int cnt[NPAIR]; };
DEV void moe_build_tab(const unsigned* cntg, LAS MoeTab* tab) {
    if (threadIdx.x == 0) {
        int ts = 0, sb = 0;
        for (int q = 0; q < NPAIR; ++q) { int n = (int)cntg[q * 32]; if (n > LISTCAP) n = LISTCAP; tab->cnt[q] = n; tab->tstart[q] = ts; tab->sbase[q] = sb; const int nt = (n + 255) >> 8; ts += nt; sb += nt << 8; }
        tab->tstart[NPAIR] = ts; tab->sbase[NPAIR] = sb;
    }
    __syncthreads();
}
DEV void pair_decode(int q, int& g, int& lo, int& hi) { g = q / 6; const int r = q - 6 * g; lo = r < 3 ? 0 : (r < 5 ? 1 : 2); hi = r < 3 ? r + 1 : (r < 5 ? r - 1 : 3); }

struct JobGateUp {
    static constexpr int K = 1024, LDB = 1024, KSPLIT = 8, SWAPPED = 0, FP8 = 1, SYNC = 1;
    P p; int layer; const LAS MoeTab* tab;
    DEV const char* bbase() const { return (const char*)(p.ws + WS_WGU); }
    DEV bool get(int i, UCtx& c, const int (&Rr)[2], const int (&Cc)[2]) const {
        int ti, pn; if (!deal(i, tab->tstart[NPAIR], 8, ti, pn)) return false;
        int q = 0; while (q < NPAIR - 1 && ti >= tab->tstart[q + 1]) ++q;
        const int tin = ti - tab->tstart[q], l0 = tin << 8, np = tab->cnt[q], slot0 = tab->sbase[q] + l0;
        int g, lo, hi; pair_decode(q, g, lo, hi);
        const int e = 4 * g + (pn < 4 ? lo : hi);
        const unsigned* list = (const unsigned*)(p.ws + WS_LIST) + (size_t)q * LISTCAP;
        c.A = (const char*)(p.ws + WS_H);
        c.B0 = (const char*)(p.ws + WS_WGU) + ((size_t)(layer * 16 + e) * 1024 + 256 * (pn & 3)) * LDB; c.B1 = c.B0;
#pragma unroll
        for (int h = 0; h < 2; ++h)
#pragma unroll
            for (int k = 0; k < 2; ++k) { int pos = l0 + 128 * h + Rr[k]; if (pos >= np) pos = 0; const unsigned tok = list[pos]; c.aoff[h][k] = tok * 1024u + (unsigned)Cc[k] * 2u; }
        c.i0 = q; c.i1 = pn; c.i2 = l0; c.i3 = np; c.i4 = slot0; c.swap = 0; return true;
    }
    DEV unsigned* tile_counter(const UCtx& c) const { return (unsigned*)(p.ws + WS_CNT + 13 * KB_) + layer * 256 + tab->tstart[c.i0] + (c.i2 >> 8); }
    DEV void epi(const f32x4 (&acc)[2][2][4][2], const UCtx& c, int wr, int wc, int fr, int fq) const {
        const int q = c.i0, pn = c.i1, l0 = c.i2, np = c.i3, slot0 = c.i4;
        const float2* sw = (const float2*)(p.ws + WS_SLOTW) + (size_t)q * LISTCAP;
        unsigned char* hid = p.ws + WS_R + R_HID;
        constexpr float ISC = 1.0f / (F8_SH * F8_SW);
        float2 w2q[2][4];
#pragma unroll
        for (int ai = 0; ai < 2; ++ai)
#pragma unroll
            for (int m = 0; m < 4; ++m) { int pos = l0 + 128 * ai + 64 * wr + 16 * m + fr; if (pos >= np) pos = np - 1; w2q[ai][m] = sw[pos]; }
        __builtin_amdgcn_sched_barrier(0);
#pragma unroll
        for (int ai = 0; ai < 2; ++ai)
#pragma unroll
            for (int m = 0; m < 4; ++m) {
                const int r = 128 * ai + 64 * wr + 16 * m + fr;
                const float2 w2 = w2q[ai][m]; const float w = (pn < 4 ? w2.x : w2.y) * (F8_SHID * ISC * ISC);
                float o[8];
#pragma unroll
                for (int n = 0; n < 2; ++n)
#pragma unroll
                    for (int k = 0; k < 4; ++k) { const float ga = acc[ai][0][m][n][k], up = acc[ai][1][m][n][k];
                        o[4 * n + k] = (w * ga) * up * __builtin_amdgcn_rcpf(1.0f + __builtin_amdgcn_exp2f(ga * (-LOG2E * ISC))); }
                u32x2 pk; pk.x = pk4_fp8(o[0], o[1], o[2], o[3]); pk.y = pk4_fp8(o[4], o[5], o[6], o[7]);
                __hip_atomic_store((unsigned long long*)(hid + (size_t)(slot0 + r) * 1024 + 128 * pn + 32 * wc + 8 * fq), ((unsigned long long)pk.y << 32) | pk.x, __ATOMIC_RELAXED, __HIP_MEMORY_SCOPE_AGENT);
            }
    }
};

template <bool OUT_F32>
struct JobDown {
    static constexpr int K = 1024, LDB = 512, KSPLIT = 4, SWAPPED = 0, FP8 = 1, SYNC = 2;
    P p; int layer; const LAS MoeTab* tab; void* outp;
    DEV const char* bbase() const { return (const char*)(p.ws + WS_WD); }
    DEV bool get(int i, UCtx& c, const int (&Rr)[2], const int (&Cc)[2]) const {
        int ti, pn; if (!deal(i, tab->tstart[NPAIR], 4, ti, pn, true)) return false;
        int q = 0; while (q < NPAIR - 1 && ti >= tab->tstart[q + 1]) ++q;
        const int tin = ti - tab->tstart[q], l0 = tin << 8, np = tab->cnt[q], slot0 = tab->sbase[q] + l0;
        int g, lo, hi; pair_decode(q, g, lo, hi);
        c.A = (const char*)(p.ws + WS_R + R_HID);
        c.B0 = (const char*)(p.ws + WS_WD) + ((size_t)(layer * 16 + 4 * g + lo) * 1024 + 256 * pn) * LDB;
        c.B1 = (const char*)(p.ws + WS_WD) + ((size_t)(layer * 16 + 4 * g + hi) * 1024 + 256 * pn) * LDB;
#pragma unroll
        for (int h = 0; h < 2; ++h)
#pragma unroll
            for (int k = 0; k < 2; ++k) c.aoff[h][k] = (unsigned)((slot0 + 128 * h + Rr[k]) * 1024 + Cc[k] * 2);
        c.i0 = q; c.i1 = pn; c.i2 = l0; c.i3 = np; c.i4 = 0; c.swap = 0; return true;
    }
    DEV unsigned* tile_counter(const UCtx& c) const { return (unsigned*)(p.ws + WS_CNT + 13 * KB_) + layer * 256 + tab->tstart[c.i0] + (c.i2 >> 8); }
    DEV void epi(const f32x4 (&acc)[2][2][4][2], const UCtx& c, int wr, int wc, int fr, int fq) const {
        const int q = c.i0, pn = c.i1, l0 = c.i2, np = c.i3;
        const unsigned* list = (const unsigned*)(p.ws + WS_LIST) + (size_t)q * LISTCAP;
        const float* gate = (const float*)(p.ws + WS_MOD) + (size_t)layer * 9 * 6144 + 5 * 1024;
        const int col0 = 256 * pn + 32 * wc + 8 * fq;
        unsigned tok[2][4];
#pragma unroll
        for (int ai = 0; ai < 2; ++ai)
#pragma unroll
            for (int m = 0; m < 4; ++m) { const int pos = l0 + 128 * ai + 64 * wr + 16 * m + fr; tok[ai][m] = list[pos < np ? pos : 0]; }
#pragma unroll
        for (int ai = 0; ai < 2; ++ai)
#pragma unroll
        for (int mp = 0; mp < 2; ++mp) {
            u32x4 bw[2][2];
            f32x4 gq[2][2][2];
#pragma unroll
            for (int mm = 0; mm < 2; ++mm) { const bf16_t* brow = (const bf16_t*)(p.ws + WS_XA) + (size_t)tok[ai][2 * mp + mm] * DM + col0;
                const float* grow_ = gate + (size_t)(tok[ai][2 * mp + mm] >> 12) * 6144 + col0;
#pragma unroll
                for (int bj = 0; bj < 2; ++bj) { bw[mm][bj] = *(const u32x4*)(brow + 128 * bj); gq[mm][bj][0] = *(const f32x4*)(grow_ + 128 * bj); gq[mm][bj][1] = *(const f32x4*)(grow_ + 128 * bj + 4); } }
            __builtin_amdgcn_sched_barrier(0);
#pragma unroll
            for (int mm = 0; mm < 2; ++mm) {
                const int m = 2 * mp + mm;
                const int pos = l0 + 128 * ai + 64 * wr + 16 * m + fr;
                const int b = (int)(tok[ai][m] >> 12);
                const size_t ooff = (size_t)tok[ai][m] * DM + col0; const float* grow = gate + (size_t)b * 6144 + col0;
                float ssq = 0.f;
                if (pos < np) {
#pragma unroll
                    for (int bj = 0; bj < 2; ++bj) {
                        const f32x4 g0 = gq[mm][bj][0], g1 = gq[mm][bj][1];
                        const u32x4 w = bw[mm][bj];
                        constexpr float ISC = 1.0f / (F8_SHID * F8_SW);
                        const f32x4 v0 = (f32x4){bflo(w.x), bfhi(w.x), bflo(w.y), bfhi(w.y)} + g0 * (acc[ai][bj][m][0] * ISC), v1 = (f32x4){bflo(w.z), bfhi(w.z), bflo(w.w), bfhi(w.w)} + g1 * (acc[ai][bj][m][1] * ISC);
                        if constexpr (OUT_F32) { *(f32x4*)((float*)outp + ooff + 128 * bj) = v0; *(f32x4*)((float*)outp + ooff + 128 * bj + 4) = v1; }
                        else { u32x4 o; o.x = pk_bf16(v0[0], v0[1]); o.y = pk_bf16(v0[2], v0[3]); o.z = pk_bf16(v1[0], v1[1]); o.w = pk_bf16(v1[2], v1[3]); *(u32x4*)((bf16_t*)outp + ooff + 128 * bj) = o;
                            ssq += bflo(o.x) * bflo(o.x) + bfhi(o.x) * bfhi(o.x) + bflo(o.y) * bflo(o.y) + bfhi(o.y) * bfhi(o.y) + bflo(o.z) * bflo(o.z) + bfhi(o.z) * bfhi(o.z) + bflo(o.w) * bflo(o.w) + bfhi(o.w) * bfhi(o.w); }
                    }
                }
                if constexpr (!OUT_F32) {
                    ssq += __shfl_xor(ssq, 16); ssq += __shfl_xor(ssq, 32);
                    if (pos < np && fq == 0) ((float*)(p.ws + WS_PART))[(size_t)tok[ai][m] * 16 + 4 * pn + wc] = ssq;
                }
            }
        }
    }
};

DEV int maprow(int map, int c) {
    if (map == 0) return c;
    if (map == 4) return l8row(c);
    if (map == 1) { const int t = c >> 8, wc = (c >> 6) & 3, bj = (c >> 5) & 1, fq = (c >> 3) & 3, n = (c >> 2) & 1, i = c & 3; return (t << 8) + bj * 128 + wc * 32 + n * 16 + fq * 4 + i; }
    const int t = c >> 7, wc = (c >> 5) & 3, fq = (c >> 3) & 3, n = (c >> 2) & 1, i = c & 3; return (t << 8) + (map == 3 ? 128 : 0) + wc * 32 + n * 16 + fq * 4 + i;
}
struct TT { const float* src; int ld; bf16_t* dst; int dstK; int map; int k0, c0; int f8; };
constexpr int NTT = 320 + 128 + 128 + 2048 * 3;
DEV void tt_decode(const P& p, int t, TT& o) {
    if (t < 320) { const int kb = t / 20, cb = t - 20 * kb; o.f8 = cb < 12 ? 1 : 0; o.src = p.mix_w_in; o.ld = 2560; o.dst = cb < 12 ? (bf16_t*)(p.ws + WS_WIN) : (bf16_t*)(p.ws + WS_WIN + 2 * MB_) - (size_t)1536 * 1024; o.dstK = 1024; o.map = 1; o.k0 = 64 * kb; o.c0 = 128 * cb; return; }
    t -= 320;
    if (t < 256) { const bool f = t >= 128; const int tt = t & 127, kb = tt >> 3, cb = tt & 7; o.f8 = 0; o.src = f ? p.fnet_w : p.mix_w_out; o.ld = 1024; o.dst = (bf16_t*)(p.ws + (f ? WS_WF : WS_WOUT)); o.dstK = 1024; o.map = f ? 0 : 4; o.k0 = 64 * kb; o.c0 = 128 * cb; return; }
    t -= 256;
    if (t < 4096) { const bool up = t >= 2048; const int tt = t & 2047, le = tt >> 6, r = tt & 63, kb = r >> 2, cb = r & 3;
        o.f8 = 1; o.src = (up ? p.wu : p.wg) + (size_t)le * 1024 * 512; o.ld = 512; o.dst = (bf16_t*)(p.ws + WS_WGU + (size_t)le * 1024 * 1024); o.dstK = 1024; o.map = up ? 3 : 2; o.k0 = 64 * kb; o.c0 = 128 * cb; return; }
    t -= 4096;
    { const int le = t >> 6, r = t & 63, kb = r >> 3, cb = r & 7; o.f8 = 1; o.src = p.wd + (size_t)le * 512 * 1024; o.ld = 1024; o.dst = (bf16_t*)(p.ws + WS_WD + (size_t)le * 1024 * 512); o.dstK = 512; o.map = 4; o.k0 = 64 * kb; o.c0 = 128 * cb; }
}
DEV void tt_load(const TT& t, f32x4 (&v)[4]) {
    const int tid = tid_(), rg = tid >> 5, c4 = tid & 31;
#pragma unroll
    for (int i = 0; i < 4; ++i) v[i] = *(const f32x4*)(t.src + (size_t)(t.k0 + (t.f8 ? 4 * rg + i : rg + 16 * i)) * t.ld + t.c0 + 4 * c4);
}
constexpr int TT_RS = 132;
constexpr int TT_RS8 = 80;
DEV void phase_prologue(const P& p, LAS unsigned char* lds) {
    const int tid = tid_(), G = (int)gridDim.x, bid = (int)blockIdx.x;
    unsigned char* ws = p.ws;
    for (int gt = bid * NTHREADS + tid; gt < 131072; gt += G * NTHREADS) {
        { const int row = gt >> 8, l = gt & 255, cc = row & 255; const int ph = (cc * l) & 255; const float ang = (float)ph * (6.283185307179586f / 256.0f);
          ((bf16_t*)(ws + WS_CS))[gt] = f2bf(row < 256 ? cosf(ang) : sinf(ang)); }
        { const int in = gt & 63, out = (gt >> 6) & 63, blk = (gt >> 12) & 7, gate = (gt >> 15) & 1, dir = (gt >> 16) & 1; const float* src = gate ? p.gi_w : p.gr_w;
          ((bf16_t*)(ws + WS_WGT))[gt] = f2bf(src[((dir * 8 + blk) * 64 + in) * 64 + out]); }
        if (gt < 8192) { const int row = gt >> 6, n1 = gt & 63, k1 = row & 63; const int ph = (k1 * n1) & 63; const float ang = (float)ph * (6.283185307179586f / 64.0f);
            ((bf16_t*)(ws + WS_F1))[gt] = f2bf(row < 64 ? cosf(ang) : -sinf(ang)); }
        if (gt < 16384) { const int half = gt >> 13, k2 = (gt >> 7) & 63, kk = gt & 127, n2 = kk & 63; const int ph = (k2 * n2) & 63; const float ang = (float)ph * (6.283185307179586f / 64.0f);
            const float cs = cosf(ang), sn = sinf(ang); const float v = half == 0 ? (kk < 64 ? cs : sn) : (kk < 64 ? -sn : cs);
            ((bf16_t*)(ws + WS_F2))[gt] = f2bf(v); }
        if (gt < 4096) { const int n2 = gt >> 6, k1 = gt & 63; const float ang = (float)(n2 * k1) * (6.283185307179586f / 4096.0f); ((float2*)(ws + WS_TW))[gt] = make_float2(cosf(ang), sinf(ang)); }
        if (gt < 3720) ((float*)(ws + WS_RPB2))[gt] = p.rpb[gt] * LOG2E;
        if (gt < 1024) { const float lm = p.lam[gt]; ((float*)(ws + WS_LA8))[gt] = -8.0f * log1pf(expf(-lm)); }
    }
    {
        LAS float* sc = (LAS float*)lds;
        LAS float* red = (LAS float*)(lds + 49152);
        { float cv[18];
#pragma unroll
          for (int q = 0; q < 18; ++q) { const int idx = tid + NTHREADS * q, b = idx >> 10, k = idx & 1023; cv[q] = b < 8 ? p.c[b * 1024 + k] : p.c_ctx[k]; }
          __builtin_amdgcn_sched_barrier(0);
#pragma unroll
          for (int q = 0; q < 18; ++q) { const int idx = tid + NTHREADS * q, b = idx >> 10, k = idx & 1023; const float v = cv[q]; sc[k * 12 + b] = v / (1.0f + __expf(-v)); } }
        __syncthreads();
        for (int task = bid; task < 768; task += G) {
            const int l = task / 384, r = task - 384 * l, chunk = r >> 2, kq = r & 3;
            const int col = tid & 63, ks = tid >> 6, n = chunk * 64 + col;
            float a[9];
#pragma unroll
            for (int b = 0; b < 9; ++b) a[b] = 0.f;
            const float* w = p.ada_w + (size_t)l * 1024 * 6144 + n; const int k0 = kq * 256 + ks * 32;
#pragma unroll 8
            for (int kk = 0; kk < 32; ++kk) { const int k = k0 + kk; const float wv = w[(size_t)k * 6144];
                const f32x4 s0 = *(const LAS f32x4*)(sc + k * 12), s1 = *(const LAS f32x4*)(sc + k * 12 + 4), s2 = *(const LAS f32x4*)(sc + k * 12 + 8);
                a[0] += wv * s0[0]; a[1] += wv * s0[1]; a[2] += wv * s0[2]; a[3] += wv * s0[3]; a[4] += wv * s1[0]; a[5] += wv * s1[1]; a[6] += wv * s1[2]; a[7] += wv * s1[3]; a[8] += wv * s2[0]; }
#pragma unroll
            for (int b = 0; b < 9; ++b) red[(ks * 64 + col) * 9 + b] = a[b];
            __syncthreads();
            if (tid < 64) {
#pragma unroll
                for (int b = 0; b < 9; ++b) { float s2 = 0.f;
#pragma unroll
                    for (int q = 0; q < 8; ++q) s2 += red[(q * 64 + tid) * 9 + b];
                    ((float*)(ws + WS_MODP))[((size_t)(kq * 2 + l) * 9 + b) * 6144 + n] = s2; }
            }
            __syncthreads();
        }
    }
    {
        LAS bf16_t* tile = (LAS bf16_t*)lds;
        int t = bid; TT cur, nx; f32x4 v[4], vn[4];
        if (t < NTT) { tt_decode(p, t, cur); tt_load(cur, v); }
        int par = 0;
        for (; t < NTT; t += G) {
            const bool hn = (t + G) < NTT;
            if (hn) { tt_decode(p, t + G, nx); tt_load(nx, vn); }
            LAS bf16_t* tl = tile + par * 64 * TT_RS;
            if (cur.f8) {
                LAS unsigned char* t8 = (LAS unsigned char*)tl;
                { const int rg = tid >> 5, c4 = tid & 31;
#pragma unroll
                  for (int j = 0; j < 4; ++j) *(LAS unsigned*)(t8 + (4 * c4 + j) * TT_RS8 + 4 * rg) = pk4_fp8(v[0][j] * F8_SW, v[1][j] * F8_SW, v[2][j] * F8_SW, v[3][j] * F8_SW); }
                __syncthreads();
                { const int cc = tid >> 2, seg = tid & 3;
                  *(u32x4*)((unsigned char*)cur.dst + (size_t)maprow(cur.map, cur.c0 + cc) * cur.dstK + cur.k0 + seg * 16) = *(const LAS u32x4*)(t8 + cc * TT_RS8 + seg * 16); }
            } else {
            { const int row = tid >> 5, c4 = tid & 31;
#pragma unroll
              for (int i = 0; i < 4; ++i) { u32x2 w; w.x = pk_bf16_asm(v[i][0], v[i][1]); w.y = pk_bf16_asm(v[i][2], v[i][3]); *(LAS u32x2*)(tl + (row + 16 * i) * TT_RS + 4 * c4) = w; } }
            __syncthreads();
#pragma unroll
            for (int j = 0; j < 2; ++j) { const int qd = tid + NTHREADS * j, cc = qd >> 3, seg = qd & 7;
                unsigned short e[8];
#pragma unroll
                for (int i = 0; i < 8; ++i) e[i] = tl[(seg * 8 + i) * TT_RS + cc];
                u32x4 w; w.x = e[0] | ((unsigned)e[1] << 16); w.y = e[2] | ((unsigned)e[3] << 16); w.z = e[4] | ((unsigned)e[5] << 16); w.w = e[6] | ((unsigned)e[7] << 16);
                *(u32x4*)(cur.dst + (size_t)maprow(cur.map, cur.c0 + cc) * cur.dstK + cur.k0 + seg * 8) = w; }
            }
            par ^= 1;
            if (hn) { cur = nx;
#pragma unroll
                for (int i = 0; i < 4; ++i) v[i] = vn[i]; }
        }
        __syncthreads();
    }
}

DEV f32x4 mod_parts4(const P& p, int l, int b, int e) {
    const float* mp = (const float*)(p.ws + WS_MODP) + ((size_t)l * 9 + b) * 6144 + e; constexpr size_t QS = (size_t)2 * 9 * 6144;
    const f32x4 a = *(const f32x4*)(mp), b1 = *(const f32x4*)(mp + QS), c = *(const f32x4*)(mp + 2 * QS), d = *(const f32x4*)(mp + 3 * QS), bs = *(const f32x4*)(p.ada_b + l * 6144 + e);
    return ((a + b1) + (c + d)) + bs;
}
DEV void phase_mod_final(const P& p) {
    const int tid = tid_();
    for (int i = (int)blockIdx.x * NTHREADS + tid; i < 2 * 9 * 6144 / 4; i += (int)gridDim.x * NTHREADS) {
        const int l = i / (9 * 1536), r = i - l * 9 * 1536, b = r / 1536, e = 4 * (r - b * 1536);
        *(f32x4*)((float*)(p.ws + WS_MOD) + ((size_t)l * 9 + b) * 6144 + e) = mod_parts4(p, l, b, e);
    }
}
template <bool PARTS, bool XBF, bool OUT8>
DEV void phase_norm_plain(const P& p, const void* xlat, int row_lo, int row_hi, int widx, int nwg, const float* gain, const float* modl  , int shift_off, int scale_off) {
    const int tid = tid_(), lane = tid & 63, wid = __builtin_amdgcn_readfirstlane(tid >> 6);
    const int gw = widx * 8 + wid, GW = nwg * 8;
    if (widx < 0) return;
    bf16_t* H = (bf16_t*)(p.ws + WS_H);
    const int nrows = row_hi - row_lo;
    const int per = (nrows + GW - 1) / GW;
    int bcur = -1; f32x4 gsc[4], sh[4];
    for (int row = row_lo + gw * per; row < row_lo + (gw + 1) * per && row < row_hi; ++row) {
        const int b = row < MTOK ? (row >> 12) : 8;
        if (b != bcur) { bcur = b; const float* mb = modl + (size_t)b * 6144;
#pragma unroll
            for (int j = 0; j < 4; ++j) { const int e = 4 * lane + 256 * j; const f32x4 g = *(const f32x4*)(gain + e); f32x4 sc;
                if constexpr (PARTS) { sc = mod_parts4(p, 0, b, scale_off + e); sh[j] = mod_parts4(p, 0, b, shift_off + e); }
                else { sc = *(const f32x4*)(mb + scale_off + e); sh[j] = *(const f32x4*)(mb + shift_off + e); }
                gsc[j] = g * (sc + 1.0f); } }
        const float* xr = row < MTOK ? (const float*)xlat + (size_t)row * DM : p.ctx + (size_t)(row - MTOK) * DM;
        f32x4 xv[4]; float ss = 0.f;
#pragma unroll
        for (int j = 0; j < 4; ++j) {
            if constexpr (XBF) { const u32x2 w = *(const u32x2*)((const bf16_t*)xlat + (size_t)row * DM + 4 * lane + 256 * j); xv[j] = (f32x4){bflo(w.x), bfhi(w.x), bflo(w.y), bfhi(w.y)}; }
            else xv[j] = *(const f32x4*)(xr + 4 * lane + 256 * j);
            ss += xv[j][0] * xv[j][0] + xv[j][1] * xv[j][1] + xv[j][2] * xv[j][2] + xv[j][3] * xv[j][3]; }
#pragma unroll
        for (int s2 = 32; s2 >= 1; s2 >>= 1) ss += __shfl_xor(ss, s2);
        const float rs = rsqrtf(ss * (1.0f / 1024.0f) + 1e-6f);
#pragma unroll
        for (int j = 0; j < 4; ++j) { const int e = 4 * lane + 256 * j;
            const f32x4 h = xv[j] * rs * gsc[j] + sh[j];
            u32x2 w; w.x = pk_bf16_asm(h[0], h[1]); w.y = pk_bf16_asm(h[2], h[3]);
            *(u32x2*)(H + (size_t)row * DM + e) = w;
            if constexpr (OUT8) *(unsigned*)((unsigned char*)p.out + (size_t)row * DM + e) = pk4_fp8(h[0] * F8_SH, h[1] * F8_SH, h[2] * F8_SH, h[3] * F8_SH); }
    }
}

DEV void phase_norm_router(const P& p, LAS unsigned char* lds, const bf16_t* xin, const float* gain, const float* modl, int layer) {
    const int tid = tid_(), lane = tid & 63, wid = __builtin_amdgcn_readfirstlane(tid >> 6);
    LAS u32x4* wh = (LAS u32x4*)lds;
    LAS u32x4* wlp = (LAS u32x4*)(lds + 32768);
    LAS float* gsl = (LAS float*)(lds + 65536 + 8192);
    LAS float* shl = (LAS float*)(lds + 65536 + 12288);
    LAS unsigned* lcnt = (LAS unsigned*)(lds + 65536);
    LAS unsigned* lbase = (LAS unsigned*)(lds + 65536 + 128);
    LAS u32x4* stash = (LAS u32x4*)(lds + 65536 + 256);
    if (tid < NPAIR) lcnt[tid] = 0u;
    bf16_t* H = (bf16_t*)(p.ws + WS_H);
    unsigned* cnt = (unsigned*)(p.ws + WS_CNT) + layer * 1024;
    unsigned* list = (unsigned*)(p.ws + WS_LIST); float2* slotw = (float2*)(p.ws + WS_SLOTW);
    const float rb = p.router_b[lane & 15];
    const int tkn = lane & 15, g = lane >> 4;
    int iter = 0;
    for (int chunk = (int)blockIdx.x; chunk < MTOK / 128; chunk += (int)gridDim.x) {
        const int b = chunk >> 5;
        const int tok0 = chunk * 128 + wid * 16;
        const bf16_t* xr = xin + (size_t)(tok0 + tkn) * DM + 8 * g;
        if (iter) __syncthreads();
        float rw[4][8], gm[2][3];
        if (iter == 0) {
#pragma unroll
            for (int i4 = 0; i4 < 4; ++i4) { const int idx = tid + NTHREADS * i4, l = idx & 63, ks = idx >> 6, e = l & 15, g2 = l >> 4;
#pragma unroll
                for (int q = 0; q < 8; ++q) rw[i4][q] = p.router_w[(32 * ks + 8 * g2 + q) * 16 + e]; }
        }
        { const float* mb = modl + (size_t)b * 6144;
#pragma unroll
          for (int kk = 0; kk < 2; ++kk) { const int k = tid + NTHREADS * kk; gm[kk][0] = gain[k]; gm[kk][1] = mb[4096 + k]; gm[kk][2] = mb[3072 + k]; } }
        u32x4 wv[32];
#pragma unroll
        for (int ks = 0; ks < 32; ++ks) wv[ks] = *(const u32x4*)(xr + 32 * ks);
        if (iter == 0) {
#pragma unroll
            for (int i4 = 0; i4 < 4; ++i4) { const int idx = tid + NTHREADS * i4; unsigned hi[4], lo[4];
#pragma unroll
                for (int q = 0; q < 4; ++q) { const float w0 = rw[i4][2 * q], w1 = rw[i4][2 * q + 1]; hi[q] = pk_bf16_asm(w0, w1); lo[q] = pk_bf16_asm(w0 - bflo(hi[q]), w1 - bfhi(hi[q])); }
                wh[idx] = (u32x4){hi[0], hi[1], hi[2], hi[3]}; wlp[idx] = (u32x4){lo[0], lo[1], lo[2], lo[3]}; }
        }
#pragma unroll
        for (int kk = 0; kk < 2; ++kk) { const int k = tid + NTHREADS * kk; gsl[k] = gm[kk][0] * (gm[kk][1] + 1.0f); shl[k] = gm[kk][2]; }
        __syncthreads();
        float ss = 0.f;
#pragma unroll
        for (int ks = 0; ks < 32; ++ks) { const u32x4 w = wv[ks]; const float a0 = bflo(w.x), a1 = bfhi(w.x), a2 = bflo(w.y), a3 = bfhi(w.y), a4 = bflo(w.z), a5 = bfhi(w.z), a6 = bflo(w.w), a7 = bfhi(w.w);
            ss += (a0 * a0 + a1 * a1) + (a2 * a2 + a3 * a3) + (a4 * a4 + a5 * a5) + (a6 * a6 + a7 * a7); }
        ss += __shfl_xor(ss, 16); ss += __shfl_xor(ss, 32);
        const float rs = rsqrtf(ss * (1.0f / 1024.0f) + 1e-6f);
        f32x4 lg = (f32x4){0.f, 0.f, 0.f, 0.f};
        unsigned char* hrow = (unsigned char*)H + (size_t)(tok0 + tkn) * DM + 8 * g;
        for (int kg = 0; kg < 4; ++kg) {
        u32x4 wb[8];
#pragma unroll
        for (int q = 0; q < 8; ++q) wb[q] = *(const u32x4*)(xr + 32 * (8 * kg + q));
        __builtin_amdgcn_sched_barrier(0);
#pragma unroll
        for (int q = 0; q < 8; ++q) { const int ks = 8 * kg + q;
            const u32x4 w = wb[q];
            const f32x4 g0 = *(const LAS f32x4*)(gsl + 32 * ks + 8 * g), g1 = *(const LAS f32x4*)(gsl + 32 * ks + 8 * g + 4), s0 = *(const LAS f32x4*)(shl + 32 * ks + 8 * g), s1 = *(const LAS f32x4*)(shl + 32 * ks + 8 * g + 4);
            const float h0 = bflo(w.x) * rs * g0[0] + s0[0], h1 = bfhi(w.x) * rs * g0[1] + s0[1], h2 = bflo(w.y) * rs * g0[2] + s0[2], h3 = bfhi(w.y) * rs * g0[3] + s0[3];
            const float h4 = bflo(w.z) * rs * g1[0] + s1[0], h5 = bfhi(w.z) * rs * g1[1] + s1[1], h6 = bflo(w.w) * rs * g1[2] + s1[2], h7 = bfhi(w.w) * rs * g1[3] + s1[3];
            u32x4 hh; hh.x = pk_bf16(h0, h1); hh.y = pk_bf16(h2, h3); hh.z = pk_bf16(h4, h5); hh.w = pk_bf16(h6, h7);
            { u32x2 h8; h8.x = pk4_fp8(h0 * F8_SH, h1 * F8_SH, h2 * F8_SH, h3 * F8_SH); h8.y = pk4_fp8(h4 * F8_SH, h5 * F8_SH, h6 * F8_SH, h7 * F8_SH); *(u32x2*)(hrow + 32 * ks) = h8; }
            u32x4 hl; hl.x = pk_bf16(h0 - bflo(hh.x), h1 - bfhi(hh.x)); hl.y = pk_bf16(h2 - bflo(hh.y), h3 - bfhi(hh.y)); hl.z = pk_bf16(h4 - bflo(hh.z), h5 - bfhi(hh.z)); hl.w = pk_bf16(h6 - bflo(hh.w), h7 - bfhi(hh.w));
            const bf16x8 ahi = __builtin_bit_cast(bf16x8, hh), alo = __builtin_bit_cast(bf16x8, hl);
            const bf16x8 bhi = __builtin_bit_cast(bf16x8, wh[ks * 64 + lane]), blo = __builtin_bit_cast(bf16x8, wlp[ks * 64 + lane]);
            lg = __builtin_amdgcn_mfma_f32_16x16x32_bf16(ahi, bhi, lg, 0, 0, 0);
            lg = __builtin_amdgcn_mfma_f32_16x16x32_bf16(ahi, blo, lg, 0, 0, 0);
            lg = __builtin_amdgcn_mfma_f32_16x16x32_bf16(alo, bhi, lg, 0, 0, 0);
        }
        }
#pragma unroll
        for (int v = 0; v < 4; ++v) {
        const float logit = lg[v];
        const float score = 1.0f / (1.0f + expf(-logit)); const float sel = score + rb;
        const int qb = lane & ~3, tb = lane & ~15;
        const float s0 = __shfl(sel, qb), s1 = __shfl(sel, qb + 1), s2 = __shfl(sel, qb + 2), s3 = __shfl(sel, qb + 3);
        const float ma = fmaxf(s0, s1), mi = fminf(s0, s1), mc = fmaxf(s2, s3), md = fminf(s2, s3);
        const float gsum = fmaxf(ma, mc) + fmaxf(fminf(ma, mc), fmaxf(mi, md));
        const float g0 = __shfl(gsum, tb), g1 = __shfl(gsum, tb + 4), g2 = __shfl(gsum, tb + 8), g3 = __shfl(gsum, tb + 12);
        int best = 0; float bv = g0; if (g1 > bv) { bv = g1; best = 1; } if (g2 > bv) { bv = g2; best = 2; } if (g3 > bv) { bv = g3; best = 3; }
        const int eb = tb + 4 * best;
        float tv[4], cv[4];
#pragma unroll
        for (int q = 0; q < 4; ++q) { tv[q] = __shfl(sel, eb + q); cv[q] = __shfl(score, eb + q); }
        int ia = 0; float va = tv[0];
#pragma unroll
        for (int q = 1; q < 4; ++q) if (tv[q] > va) { va = tv[q]; ia = q; }
        int ib = -1; float vb = -3.0e38f;
#pragma unroll
        for (int q = 0; q < 4; ++q) if (q != ia && tv[q] > vb) { vb = tv[q]; ib = q; }
        float sa = 0.f, sb = 0.f;
#pragma unroll
        for (int q = 0; q < 4; ++q) { sa = (q == ia) ? cv[q] : sa; sb = (q == ib) ? cv[q] : sb; }
        const float inv = 1.0f / (sa + sb); const float wa = sa * inv, wb = sb * inv;
        const int lo = ia < ib ? ia : ib, hi = ia < ib ? ib : ia; const float wlo = ia < ib ? wa : wb, whi = ia < ib ? wb : wa;
        const int pidx = lo == 0 ? hi - 1 : (lo == 1 ? hi + 1 : 5);
        const int pair = best * 6 + pidx; const float wlo_ = wlo, whi_ = whi;
        if ((lane & 15) == 0) {
            const unsigned lpos = __hip_atomic_fetch_add(&lcnt[pair], 1u, __ATOMIC_RELAXED, __HIP_MEMORY_SCOPE_WORKGROUP);
            stash[(wid * 8 + iter * 4 + v) * 4 + (lane >> 4)] = (u32x4){(unsigned)pair, lpos, __float_as_uint(wlo_), __float_as_uint(whi_)};
        }
        }
        ++iter;
    }
    __syncthreads();
    if (tid < NPAIR) lbase[tid] = atomicAdd(&cnt[tid * 32], lcnt[tid]);
    __syncthreads();
    if (lane < 4) {
        int it2 = 0;
        for (int chunk = (int)blockIdx.x; chunk < MTOK / 128; chunk += (int)gridDim.x, ++it2) {
#pragma unroll
            for (int v = 0; v < 4; ++v) {
                const u32x4 sv = stash[(wid * 8 + it2 * 4 + v) * 4 + lane];
                const unsigned pair = sv.x, pos = lbase[pair] + sv.y;
                if (pos < (unsigned)LISTCAP) { list[(size_t)pair * LISTCAP + pos] = (unsigned)(chunk * 128 + wid * 16 + 4 * lane + v); slotw[(size_t)pair * LISTCAP + pos] = make_float2(__uint_as_float(sv.z), __uint_as_float(sv.w)); }
            }
        }
    }
    __syncthreads();
}

constexpr int AT_KC = 0, AT_KROW = 144;
constexpr int AT_VC = 256 * AT_KROW, AT_VROW = 528;
constexpr int AT_TB = AT_VC + 64 * AT_VROW;
constexpr int AT_IX = AT_TB + 2048;
DEV void phase_attention(const P& p, LAS unsigned char* lds) {
    const int tid = tid_(), lane = tid & 63, wid = __builtin_amdgcn_readfirstlane(tid >> 6);
    const unsigned char* R = p.ws + WS_R;
    const bf16_t* Q = (const bf16_t*)(R + R_Q); const bf16_t* Kb = (const bf16_t*)(R + R_K); const bf16_t* VT = (const bf16_t*)(R + R_VT);
    const bf16_t* KC = (const bf16_t*)(R + R_KC); const bf16_t* VCT = (const bf16_t*)(R + R_VCT);
    bf16_t* MIX = (bf16_t*)(p.ws + WS_R + R_MIX);
    const float* rpb2 = (const float*)(p.ws + WS_RPB2);
    if (tid < 64) {
#pragma unroll
        for (int cm = 0; cm < 6; ++cm) {
            const int c = cm / 3, cb = cm - 3 * c + c, qc = 16 * cb + (lane & 15), cs = clampi(qc - 8, 0, 48);
            unsigned w0 = 0u, w1 = 0u;
#pragma unroll
            for (int t = 0; t < 8; ++t) { const int kc = 32 * c + 8 * (lane >> 4) + t; const bool valid = kc >= cs && kc < cs + 16; const unsigned id = valid ? (unsigned)(clampi(kc - qc, -15, 15) + 15) : 31u;
                if (t < 4) w0 |= (id * 4u) << (8 * t); else w1 |= (id * 4u) << (8 * (t - 4)); }
            *(LAS u32x2*)(lds + AT_IX + (cm * 64 + lane) * 8) = (u32x2){w0, w1};
        }
    }
    const int nun = NB * 8 * 8, uper = (nun + (int)gridDim.x - 1) / (int)gridDim.x;
    int staged = -1;
    for (int u = (int)blockIdx.x * uper; u < ((int)blockIdx.x + 1) * uper && u < nun; ++u) {
        const int band = u & 7, h = (u >> 3) & 7, b = u >> 6;
        __syncthreads();
        int tl = tid; asm volatile("" : "+v"(tl));
        if ((u >> 3) != staged) { staged = u >> 3;
#pragma unroll
        for (int i = 0; i < 4; ++i) { const int cid = tl + NTHREADS * i;
            { const int key = cid >> 3, part = cid & 7; *(LAS u32x4*)(lds + AT_KC + key * AT_KROW + part * 16) = *(const u32x4*)(KC + (size_t)(b * CTXL + key) * 512 + h * 64 + part * 8); }
            { const int d = cid >> 5, part = cid & 31; *(LAS u32x4*)(lds + AT_VC + d * AT_VROW + part * 16) = *(const u32x4*)(VCT + (size_t)((b * 8 + h) * 64 + d) * CTXL + part * 8); } }
        if (tl < 480) { const int dr = tl >> 5, q = tl & 31; ((LAS float*)(lds + AT_TB))[tl] = q < 31 ? rpb2[h * 465 + dr * 31 + q] : -1.0e30f; }
        }
        __syncthreads();
        int ln = lane; asm volatile("" : "+v"(ln));
        const int j = ln & 15, g = ln >> 4, kap0 = 8 * (j >> 2) + (j & 3);
        const int r = 8 * band + wid;
        const int rs = clampi(r - 4, 0, 56);
        bf16x8 qf[4][2];
#pragma unroll
        for (int cb = 0; cb < 4; ++cb)
#pragma unroll
            for (int ks = 0; ks < 2; ++ks) qf[cb][ks] = *(const bf16x8*)(Q + (size_t)(b * SEQ + r * 64 + 16 * cb + j) * 512 + h * 64 + 32 * ks + 8 * g);
        f32x4 O[4][4]; float l[4];
#pragma unroll
        for (int cb = 0; cb < 4; ++cb) { l[cb] = 0.f;
#pragma unroll
            for (int db = 0; db < 4; ++db) O[cb][db] = (f32x4){0.f, 0.f, 0.f, 0.f}; }
        const bf16_t* vtb = VT + (size_t)((b * 8 + h) * 64 + j) * SEQ;
#define AT_LOADW(KF, VF, krow_, c_) do { const int ktok0_ = b * SEQ + (krow_) * 64 + 32 * (c_); \
            _Pragma("unroll") for (int blk = 0; blk < 2; ++blk) _Pragma("unroll") for (int ks = 0; ks < 2; ++ks) KF[blk][ks] = *(const bf16x8*)(Kb + (size_t)(ktok0_ + kap0 + 4 * blk) * 512 + h * 64 + 32 * ks + 8 * g); \
            _Pragma("unroll") for (int db = 0; db < 4; ++db) VF[db] = *(const bf16x8*)(vtb + (size_t)(16 * db) * SEQ + (krow_) * 64 + 32 * (c_) + 8 * g); } while (0)
#define AT_EVALW(KF, VF, c_) do { _Pragma("unroll") for (int q3 = 0; q3 < 3; ++q3) { const int cb = q3 + (c_), cm = 3 * (c_) + q3; f32x4 s_[2]; \
            _Pragma("unroll") for (int blk = 0; blk < 2; ++blk) { s_[blk] = __builtin_amdgcn_mfma_f32_16x16x32_bf16(KF[blk][0], qf[cb][0], (f32x4){0.f, 0.f, 0.f, 0.f}, 0, 0, 0); \
                s_[blk] = __builtin_amdgcn_mfma_f32_16x16x32_bf16(KF[blk][1], qf[cb][1], s_[blk], 0, 0, 0); } \
            float pv[8]; const u32x2 iw2 = *(const LAS u32x2*)(lds + AT_IX + (cm * 64 + ln) * 8); const unsigned iw[2] = {iw2.x, iw2.y}; \
            _Pragma("unroll") for (int t = 0; t < 8; ++t) { const unsigned off = (iw[t >> 2] >> (8 * (t & 3))) & 0xffu; const float bias = *(const LAS float*)(lds + tbrow + off); \
                pv[t] = __builtin_amdgcn_exp2f(s_[t >> 2][t & 3] + bias); l[cb] += pv[t]; } \
            u32x4 pw; pw.x = pk_bf16(pv[0], pv[1]); pw.y = pk_bf16(pv[2], pv[3]); pw.z = pk_bf16(pv[4], pv[5]); pw.w = pk_bf16(pv[6], pv[7]); \
            const bf16x8 pf = __builtin_bit_cast(bf16x8, pw); \
            _Pragma("unroll") for (int db = 0; db < 4; ++db) O[cb][db] = __builtin_amdgcn_mfma_f32_16x16x32_bf16(VF[db], pf, O[cb][db], 0, 0, 0); \
            if (q3 == 2) __builtin_amdgcn_sched_barrier(0); } } while (0)
#define AT_LOADC(KF, VF, c_) do { _Pragma("unroll") for (int blk = 0; blk < 2; ++blk) _Pragma("unroll") for (int ks = 0; ks < 2; ++ks) \
                KF[blk][ks] = *(const LAS bf16x8*)(lds + AT_KC + (32 * (c_) + kap0 + 4 * blk) * AT_KROW + ks * 64 + g * 16); \
            _Pragma("unroll") for (int db = 0; db < 4; ++db) VF[db] = *(const LAS bf16x8*)(lds + AT_VC + (16 * db + j) * AT_VROW + (c_) * 64 + g * 16); } while (0)
#define AT_EVALC(KF, VF, CB0) do { _Pragma("unroll") for (int cb = (CB0); cb < (CB0) + 2; ++cb) { f32x4 s_[2]; \
            _Pragma("unroll") for (int blk = 0; blk < 2; ++blk) { s_[blk] = __builtin_amdgcn_mfma_f32_16x16x32_bf16(KF[blk][0], qf[cb][0], (f32x4){0.f, 0.f, 0.f, 0.f}, 0, 0, 0); \
                s_[blk] = __builtin_amdgcn_mfma_f32_16x16x32_bf16(KF[blk][1], qf[cb][1], s_[blk], 0, 0, 0); } \
            float pv[8]; _Pragma("unroll") for (int t = 0; t < 8; ++t) { pv[t] = __builtin_amdgcn_exp2f(s_[t >> 2][t & 3]); l[cb] += pv[t]; } \
            u32x4 pw; pw.x = pk_bf16(pv[0], pv[1]); pw.y = pk_bf16(pv[2], pv[3]); pw.z = pk_bf16(pv[4], pv[5]); pw.w = pk_bf16(pv[6], pv[7]); \
            const bf16x8 pf = __builtin_bit_cast(bf16x8, pw); \
            _Pragma("unroll") for (int db = 0; db < 4; ++db) O[cb][db] = __builtin_amdgcn_mfma_f32_16x16x32_bf16(VF[db], pf, O[cb][db], 0, 0, 0); \
            if (cb & 1) __builtin_amdgcn_sched_barrier(0); } } while (0)
        {
            bf16x8 kfa[2][2], vfa[4], kfb[2][2], vfb[4];
            AT_LOADW(kfa, vfa, rs, 0);
            for (int i = 0; i < 8; ++i) {
                const int krow = rs + i;
                const unsigned tbrow = (unsigned)(AT_TB + (krow - r + 7) * 128);
                AT_LOADW(kfb, vfb, krow, 1);
                __builtin_amdgcn_sched_barrier(0);
                AT_EVALW(kfa, vfa, 0);
                AT_LOADC(kfa, vfa, i);
                AT_EVALC(kfa, vfa, 0);
                { const int kn = i < 7 ? krow + 1 : krow; AT_LOADW(kfa, vfa, kn, 0); }
                __builtin_amdgcn_sched_barrier(0);
                AT_EVALW(kfb, vfb, 1);
                AT_LOADC(kfb, vfb, i);
                AT_EVALC(kfb, vfb, 2);
            }
        }
#undef AT_LOADW
#undef AT_EVALW
#undef AT_LOADC
#undef AT_EVALC
#pragma unroll
        for (int cb = 0; cb < 4; ++cb) {
            float lt = l[cb]; lt += __shfl_xor(lt, 16); lt += __shfl_xor(lt, 32);
            const float inv = 1.0f / lt;
            const size_t qtok = (size_t)b * SEQ + r * 64 + 16 * cb + j;
#pragma unroll
            for (int db = 0; db < 4; ++db) { const f32x4 o = O[cb][db] * inv; u32x2 w; w.x = pk_bf16(o[0], o[1]); w.y = pk_bf16(o[2], o[3]);
                *(u32x2*)(MIX + qtok * DM + h * 64 + 16 * db + 4 * g) = w; }
        }
    }
    __syncthreads();
}

DEV float fast_sigmoid(float z) { return __builtin_amdgcn_rcpf(1.0f + __builtin_amdgcn_exp2f(-LOG2E * z)); }
struct LruGates { f32x16 acc[4]; f32x16 xc; bool poly; };
DEV void lru_xload(const bf16_t* xb, int T, int p0, int cg, int lane, u32x4 (&xw)[2][4], int& okm) {
    const int blk = cg >> 1, half = cg & 1, i = lane & 31, hh = lane >> 5;
    const int pos = p0 + 16 * ((i >> 2) & 1) + 4 * (i >> 3) + (i & 3);
    const __amdgpu_buffer_rsrc_t rs = __builtin_amdgcn_make_buffer_rsrc((void*)xb, 0, T * 1024, 0x00020000);
    okm = 15;
#pragma unroll
    for (int tap = 0; tap < 4; ++tap) { const int vo = (pos + tap - 2) * 1024 + (64 * blk + 32 * half + 8 * hh) * 2;
#pragma unroll
        for (int kk = 0; kk < 2; ++kk) xw[kk][tap] = __builtin_bit_cast(u32x4, __builtin_amdgcn_raw_buffer_load_b128(rs, vo + 32 * kk, 0, 0)); }
}
DEV void lru_gates(const P& p, const LAS float* cw, LAS unsigned char* xl  , int wid, int cg, int lane, const u32x4 (&xw)[2][4], int okm, const float (&la8)[2], LruGates& G) {
    const int blk = cg >> 1, half = cg & 1, i = lane & 31, hh = lane >> 5;
    const bf16_t* wgt = (const bf16_t*)(p.ws + WS_WGT) + (size_t)(blk * 64 + 32 * half + i) * 64 + 8 * hh;
#pragma unroll
    for (int gd = 0; gd < 4; ++gd)
#pragma unroll
        for (int q = 0; q < 16; ++q) G.acc[gd][q] = 0.f;
#pragma unroll
    for (int q = 0; q < 16; ++q) G.xc[q] = 0.f;
#pragma unroll
    for (int kk = 0; kk < 2; ++kk) {
        const int ks = 2 * half + kk;
        bf16x8 bw[4];
#pragma unroll
        for (int gd = 0; gd < 4; ++gd) bw[gd] = *(const bf16x8*)(wgt + gd * (8 * 64 * 64) + 16 * ks);
        const int ch0 = 64 * blk + 16 * ks + 8 * hh;
        float xc[8];
        { const f32x4 b0 = *(const LAS f32x4*)(cw + 2048 + ch0), b1 = *(const LAS f32x4*)(cw + 2048 + ch0 + 4);
          xc[0] = b0[0]; xc[1] = b0[1]; xc[2] = b0[2]; xc[3] = b0[3]; xc[4] = b1[0]; xc[5] = b1[1]; xc[6] = b1[2]; xc[7] = b1[3]; }
#pragma unroll
        for (int tap = 0; tap < 4; ++tap) {
            const f32x4 w0 = *(const LAS f32x4*)(cw + tap * 512 + ch0), w1 = *(const LAS f32x4*)(cw + tap * 512 + ch0 + 4);
            const u32x4 x = xw[kk][tap];
            xc[0] += w0[0] * bflo(x.x); xc[1] += w0[1] * bfhi(x.x); xc[2] += w0[2] * bflo(x.y); xc[3] += w0[3] * bfhi(x.y);
            xc[4] += w1[0] * bflo(x.z); xc[5] += w1[1] * bfhi(x.z); xc[6] += w1[2] * bflo(x.w); xc[7] += w1[3] * bfhi(x.w);
        }
        u32x4 aw; aw.x = pk_bf16(xc[0], xc[1]); aw.y = pk_bf16(xc[2], xc[3]); aw.z = pk_bf16(xc[4], xc[5]); aw.w = pk_bf16(xc[6], xc[7]);
        *(LAS u32x4*)(xl + wid * 2048 + kk * 1024 + lane * 16) = aw;
        const bf16x8 af = __builtin_bit_cast(bf16x8, aw);
#pragma unroll
        for (int gd = 0; gd < 4; ++gd) G.acc[gd] = __builtin_amdgcn_mfma_f32_32x32x16_bf16(af, bw[gd], G.acc[gd], 0, 0, 0);
        {
            const int tt = i - 16 * kk - 8 * hh;
            u32x4 idw = (u32x4){0u, 0u, 0u, 0u};
            const unsigned one = (tt >= 0 && tt < 8) ? (0x3F80u << (16 * (tt & 1))) : 0u;
            idw.x = (tt >> 1) == 0 ? one : 0u; idw.y = (tt >> 1) == 1 ? one : 0u; idw.z = (tt >> 1) == 2 ? one : 0u; idw.w = (tt >> 1) == 3 ? one : 0u;
            G.xc = __builtin_amdgcn_mfma_f32_32x32x16_bf16(af, __builtin_bit_cast(bf16x8, idw), G.xc, 0, 0, 0);
        }
        __builtin_amdgcn_sched_barrier(0);
    }
    __syncthreads();
#pragma unroll
    for (int kk = 0; kk < 2; ++kk) {
        const int ks = 2 * (1 - half) + kk;
        bf16x8 bw[4];
#pragma unroll
        for (int gd = 0; gd < 4; ++gd) bw[gd] = *(const bf16x8*)(wgt + gd * (8 * 64 * 64) + 16 * ks);
        const bf16x8 af = *(const LAS bf16x8*)(xl + (wid ^ 1) * 2048 + kk * 1024 + lane * 16);
#pragma unroll
        for (int gd = 0; gd < 4; ++gd) G.acc[gd] = __builtin_amdgcn_mfma_f32_32x32x16_bf16(af, bw[gd], G.acc[gd], 0, 0, 0);
        __builtin_amdgcn_sched_barrier(0);
    }
    asm volatile("s_nop 15\n\ts_nop 15" ::: "memory");
    __builtin_amdgcn_sched_barrier(0);
    G.poly = !__any((la8[0] < -0.25f) || (la8[1] < -0.25f));
}
DEV void lru_elem(const LruGates& G, int r, int d, const float (&la8)[2], const float (&br)[2], const float (&bi)[2], float& a, float& bt) {
    const float rg = fast_sigmoid(G.acc[2 * d][r] + br[d]), ig = fast_sigmoid(G.acc[2 * d + 1][r] + bi[d]);
    const float x = rg * la8[d]; float m;
    if (G.poly) { const float e1 = x * (1.0f + x * (0.5f + x * (0.16666667f + x * (0.041666668f + x * 0.0083333338f)))); a = 1.0f + e1; m = -e1 * (2.0f + e1); }
    else { a = __builtin_amdgcn_exp2f(LOG2E * x); m = 1.0f - __builtin_amdgcn_exp2f(2.0f * LOG2E * x); }
    bt = __builtin_amdgcn_sqrtf(m) * ig * G.xc[r];
}
DEV void lru_load_w(const P& p, int cg, int lane, float (&la8)[2], float (&br)[2], float (&bi)[2]) {
    const int c = 64 * (cg >> 1) + 32 * (cg & 1) + (lane & 31);
#pragma unroll
    for (int d = 0; d < 2; ++d) { la8[d] = ((const float*)(p.ws + WS_LA8))[d * 512 + c]; br[d] = p.gr_b[d * 512 + c]; bi[d] = p.gi_b[d * 512 + c]; }
}
DEV void phase_lru1(const P& p, LAS unsigned char* lds) {
    const int tid = tid_(), lane = tid & 63, wid = __builtin_amdgcn_readfirstlane(tid >> 6);
    const int gw = (int)blockIdx.x * 8 + wid, GW = (int)gridDim.x * 8;
    const int cg = gw & 15, hh = lane >> 5;
    LAS float* cw = (LAS float*)lds;
    for (int q = tid; q < 2560; q += NTHREADS) cw[q] = q < 2048 ? p.conv_w[q] : p.conv_b[q - 2048];
    __syncthreads();
    float la8[2], br[2], bi[2];
    lru_load_w(p, cg, lane, la8, br, bi);
    const bf16_t* XB = (const bf16_t*)(p.ws + WS_R + R_XB); const bf16_t* XBC = (const bf16_t*)(p.ws + WS_R + R_XBC);
    float2* SUM = (float2*)(p.ws + WS_SUM);
    unsigned* AB = (unsigned*)p.out;
    const int c = 64 * (cg >> 1) + 32 * (cg & 1) + (lane & 31);
    const int it0 = gw >> 4, itS = GW >> 4;
    u32x4 xw[2][4]; int okm = 0; int trip = 0;
    LAS unsigned char* xex = lds + 12288;
    if (it0 < NB * 136) { const int b = it0 / 136, tile = it0 - 136 * b; const bool isc = tile < 8;
        lru_xload(isc ? XBC + (size_t)b * CTXL * 512 : XB + (size_t)b * SEQ * 512, isc ? CTXL : SEQ, isc ? 32 * tile : 32 * (tile - 8), cg, lane, xw, okm); }
    for (int it = it0; it < NB * 136; it += itS) {
        const int b = it / 136, tile = it - 136 * b;
        const bool isc = tile < 8;
        int ln = lane; asm volatile("" : "+v"(ln));
        LruGates G; lru_gates(p, cw, xex + (trip & 1) * 16384, wid, cg, ln, xw, okm, la8, G); ++trip;
        { const int itn = it + itS;
          if (itn < NB * 136) { const int bn = itn / 136, tn = itn - 136 * bn; const bool iscn = tn < 8;
              lru_xload(iscn ? XBC + (size_t)bn * CTXL * 512 : XB + (size_t)bn * SEQ * 512, iscn ? CTXL : SEQ, iscn ? 32 * tn : 32 * (tn - 8), cg, lane, xw, okm); } }
        unsigned* ab = AB + ((size_t)((b * 128 + (tile - 8)) * 16 + cg) * 32) * 64 + ln;
        float Af = 1.f, Hf = 0.f, Ab = 1.f, Hb = 0.f;
#pragma unroll
        for (int rp = 0; rp < 8; ++rp) {
            float a0, t0, a1, t1; lru_elem(G, 2 * rp, 0, la8, br, bi, a0, t0); lru_elem(G, 2 * rp + 1, 0, la8, br, bi, a1, t1);
            const unsigned ua = pk_bf16(1.0f - a0, 1.0f - a1), ut = pk_bf16(t0, t1);
            if (!isc) { ab[(0 * 8 + rp) * 64] = ua; ab[(1 * 8 + rp) * 64] = ut; }
            a0 = 1.0f - bflo(ua); a1 = 1.0f - bfhi(ua); t0 = bflo(ut); t1 = bfhi(ut);
            Hf = a0 * Hf + t0; Af *= a0; Hf = a1 * Hf + t1; Af *= a1;
            __builtin_amdgcn_sched_barrier(0);
        }
#pragma unroll
        for (int rp = 7; rp >= 0; --rp) {
            float a0, t0, a1, t1; lru_elem(G, 2 * rp, 1, la8, br, bi, a0, t0); lru_elem(G, 2 * rp + 1, 1, la8, br, bi, a1, t1);
            const unsigned ua = pk_bf16(1.0f - a0, 1.0f - a1), ut = pk_bf16(t0, t1);
            if (!isc) { ab[(2 * 8 + rp) * 64] = ua; ab[(3 * 8 + rp) * 64] = ut; }
            a0 = 1.0f - bflo(ua); a1 = 1.0f - bfhi(ua); t0 = bflo(ut); t1 = bfhi(ut);
            Hb = a1 * Hb + t1; Ab *= a1; Hb = a0 * Hb + t0; Ab *= a0;
            __builtin_amdgcn_sched_barrier(0);
        }
        const float oAf = __shfl_xor(Af, 32), oHf = __shfl_xor(Hf, 32), oAb = __shfl_xor(Ab, 32), oHb = __shfl_xor(Hb, 32);
        const float Af_lo = hh ? oAf : Af, Hf_lo = hh ? oHf : Hf, Af_up = hh ? Af : oAf, Hf_up = hh ? Hf : oHf;
        const float Ab_lo = hh ? oAb : Ab, Hb_lo = hh ? oHb : Hb, Ab_up = hh ? Ab : oAb, Hb_up = hh ? Hb : oHb;
        const float2 fw = make_float2(Af_lo * Af_up, Af_up * Hf_lo + Hf_up);
        const float2 bw = make_float2(Ab_lo * Ab_up, Ab_lo * Hb_up + Hb_lo);
        SUM[((size_t)(b * 136 + tile) * 2 + (ln >> 5)) * 512 + 64 * (cg >> 1) + 32 * (cg & 1) + (ln & 31)] = (ln >> 5) ? bw : fw;
    }
}
DEV void phase_lru_carry(const P& p) {
    const int tid = tid_(), lane = tid & 63;
    const int gwv = (int)blockIdx.x * 8 + __builtin_amdgcn_readfirstlane(tid >> 6);
    if (gwv >= NB * 2 * 64) return;
    const int seg = lane >> 3, c = (gwv & 63) * 8 + (lane & 7), dir = (gwv >> 6) & 1, b = gwv >> 7;
    const float2* SUM = (const float2*)(p.ws + WS_SUM); float* CAR = (float*)(p.ws + WS_CAR);
    float2 sv[17]; int tl[17];
#pragma unroll
    for (int q = 0; q < 17; ++q) { const int o = 17 * seg + q; tl[q] = dir == 0 ? o : (o < 8 ? 7 - o : 143 - o); sv[q] = SUM[((size_t)(b * 136 + tl[q]) * 2 + dir) * 512 + c]; }
    float A = 1.f, H = 0.f;
#pragma unroll
    for (int q = 0; q < 17; ++q) { H = sv[q].x * H + sv[q].y; A *= sv[q].x; }
    float h = 0.f, mine = 0.f;
#pragma unroll
    for (int sg = 0; sg < 8; ++sg) { const float As = __shfl(A, sg * 8 + (lane & 7)), Hs = __shfl(H, sg * 8 + (lane & 7)); if (sg == seg) mine = h; h = As * h + Hs; }
    h = mine;
#pragma unroll
    for (int q = 0; q < 17; ++q) { if (tl[q] >= 8) CAR[((size_t)(b * 128 + tl[q] - 8) * 2 + dir) * 512 + c] = h; h = sv[q].x * h + sv[q].y; }
}
DEV void phase_lru2(const P& p) {
    const int tid = tid_(), lane = tid & 63, wid = __builtin_amdgcn_readfirstlane(tid >> 6);
    const int gw = (int)blockIdx.x * 8 + wid, GW = (int)gridDim.x * 8;
    const int cg = gw & 15, hh = lane >> 5;
    const bf16_t* GB = (const bf16_t*)(p.ws + WS_R + R_GB);
    bf16_t* MIX = (bf16_t*)(p.ws + WS_R + R_MIX);
    const float* CAR = (const float*)(p.ws + WS_CAR);
    const unsigned* AB = (const unsigned*)p.out;
    const int c = 64 * (cg >> 1) + 32 * (cg & 1) + (lane & 31);
    for (int it = gw >> 4; it < NB * 128; it += GW >> 4) {
        const int b = it >> 7, tile = it & 127, p0 = 32 * tile;
        const unsigned* ab = AB + ((size_t)((b * 128 + tile) * 16 + cg) * 32) * 64 + lane;
        unsigned u[4][8];
#pragma unroll
        for (int k = 0; k < 4; ++k)
#pragma unroll
            for (int rp = 0; rp < 8; ++rp) u[k][rp] = ab[(k * 8 + rp) * 64];
        const float cf = CAR[((size_t)(b * 128 + tile) * 2 + 0) * 512 + c], cbk = CAR[((size_t)(b * 128 + tile) * 2 + 1) * 512 + c];
        unsigned short gbv[16];
#pragma unroll
        for (int r = 0; r < 16; ++r) gbv[r] = GB[((size_t)b * SEQ + p0 + 16 * hh + r) * 512 + c];
        float y[16], Pf[16], Pb[16];
        float Af = 1.f, Hf = 0.f, Ab = 1.f, Hb = 0.f;
#pragma unroll
        for (int rp = 0; rp < 8; ++rp) {
            const float a0 = 1.0f - bflo(u[0][rp]), a1 = 1.0f - bfhi(u[0][rp]), t0 = bflo(u[1][rp]), t1 = bfhi(u[1][rp]);
            Hf = a0 * Hf + t0; Af *= a0; y[2 * rp] = Hf; Pf[2 * rp] = Af;
            Hf = a1 * Hf + t1; Af *= a1; y[2 * rp + 1] = Hf; Pf[2 * rp + 1] = Af;
        }
#pragma unroll
        for (int rp = 7; rp >= 0; --rp) {
            const float a0 = 1.0f - bflo(u[2][rp]), a1 = 1.0f - bfhi(u[2][rp]), t0 = bflo(u[3][rp]), t1 = bfhi(u[3][rp]);
            Hb = a1 * Hb + t1; Ab *= a1; y[2 * rp + 1] += Hb; Pb[2 * rp + 1] = Ab;
            Hb = a0 * Hb + t0; Ab *= a0; y[2 * rp] += Hb; Pb[2 * rp] = Ab;
        }
        const float oAf = __shfl_xor(Af, 32), oHf = __shfl_xor(Hf, 32), oAb = __shfl_xor(Ab, 32), oHb = __shfl_xor(Hb, 32);
        const float sf = hh ? (oAf * cf + oHf) : cf;
        const float sb = hh ? cbk : (oAb * cbk + oHb);
#pragma unroll
        for (int r = 0; r < 16; ++r) { const size_t tok = (size_t)b * SEQ + p0 + 16 * hh + r;
            MIX[tok * DM + 512 + c] = f2bf(bf2f(gbv[r]) * (y[r] + Pf[r] * sf + Pb[r] * sb)); }
    }
}

DEV unsigned perm_lo(unsigned w1, unsigned w0) { return __builtin_amdgcn_perm(w1, w0, 0x05040100u); }
DEV unsigned perm_hi(unsigned w1, unsigned w0) { return __builtin_amdgcn_perm(w1, w0, 0x07060302u); }
DEV void phase_fnet_s1(const P& p, LAS unsigned char* lds) {
    const int tid = tid_(), lane = tid & 63, wid = __builtin_amdgcn_readfirstlane(tid >> 6);
    const int gw = (int)blockIdx.x * 8 + wid, GW = (int)gridDim.x * 8;
    const int jj = lane & 31, hh = lane >> 5;
    const bf16_t* F1 = (const bf16_t*)(p.ws + WS_F1); const bf16_t* H = (const bf16_t*)(p.ws + WS_XA);
    const float* PART = (const float*)(p.ws + WS_PART); const float* modl = (const float*)(p.ws + WS_MOD) + 9 * 6144; const float* gain = p.norm_mix + DM;
    LAS float* rsl = (LAS float*)lds + 64 * wid;
    bf16_t* T = (bf16_t*)(p.ws + WS_R + R_T); const float2* TW = (const float2*)(p.ws + WS_TW);
    bf16x8 Af[4][4];
#pragma unroll
    for (int ib = 0; ib < 4; ++ib)
#pragma unroll
        for (int ks = 0; ks < 4; ++ks) Af[ib][ks] = *(const bf16x8*)(F1 + (size_t)(32 * ib + jj) * 64 + 16 * ks + 8 * hh);
    for (int it = gw; it < NB * 64 * 16; it += GW) {
        const int cb = it & 15, n2 = (it >> 4) & 63, b = it >> 10;
        const int col = 64 * cb + 2 * jj;
        const bf16_t* hb = H + ((size_t)b * SEQ + n2) * DM + col;
        { const float* pr = PART + ((size_t)b * SEQ + 64 * lane + n2) * 16;
          const f32x4 a0 = *(const f32x4*)pr, a1 = *(const f32x4*)(pr + 4), a2 = *(const f32x4*)(pr + 8), a3 = *(const f32x4*)(pr + 12);
          const f32x4 a = (a0 + a1) + (a2 + a3);
          rsl[lane] = rsqrtf(((a[0] + a[1]) + (a[2] + a[3])) * (1.0f / 1024.0f) + 1e-6f); }
        const float2 g2 = *(const float2*)(gain + col), sc2 = *(const float2*)(modl + (size_t)b * 6144 + 1024 + col), sh2 = *(const float2*)(modl + (size_t)b * 6144 + col);
        const float gs0 = g2.x * (sc2.x + 1.0f), gs1 = g2.y * (sc2.y + 1.0f);
        __builtin_amdgcn_fence(__ATOMIC_RELEASE, "wavefront"); __builtin_amdgcn_wave_barrier(); __builtin_amdgcn_fence(__ATOMIC_ACQUIRE, "wavefront");
        bf16x8 Bf[2][4];
#pragma unroll
        for (int ks = 0; ks < 4; ++ks) {
            unsigned w[8];
#pragma unroll
            for (int t = 0; t < 8; ++t) w[t] = *(const unsigned*)(hb + (size_t)(64 * (16 * ks + 8 * hh + t)) * DM);
            const f32x4 r0 = *(const LAS f32x4*)(rsl + 16 * ks + 8 * hh), r1 = *(const LAS f32x4*)(rsl + 16 * ks + 8 * hh + 4);
            const float rv[8] = {r0[0], r0[1], r0[2], r0[3], r1[0], r1[1], r1[2], r1[3]};
            float h0[8], h1[8];
#pragma unroll
            for (int t = 0; t < 8; ++t) { h0[t] = bflo(w[t]) * rv[t] * gs0 + sh2.x; h1[t] = bfhi(w[t]) * rv[t] * gs1 + sh2.y; }
            u32x4 e0, e1;
            e0.x = pk_bf16(h0[0], h0[1]); e0.y = pk_bf16(h0[2], h0[3]); e0.z = pk_bf16(h0[4], h0[5]); e0.w = pk_bf16(h0[6], h0[7]);
            e1.x = pk_bf16(h1[0], h1[1]); e1.y = pk_bf16(h1[2], h1[3]); e1.z = pk_bf16(h1[4], h1[5]); e1.w = pk_bf16(h1[6], h1[7]);
            Bf[0][ks] = __builtin_bit_cast(bf16x8, e0); Bf[1][ks] = __builtin_bit_cast(bf16x8, e1);
        }
        __builtin_amdgcn_wave_barrier();
#pragma unroll
        for (int ib2 = 0; ib2 < 2; ++ib2) {
            f32x16 D[2][2];
#pragma unroll
            for (int st = 0; st < 2; ++st)
#pragma unroll
                for (int ri = 0; ri < 2; ++ri) {
#pragma unroll
                    for (int q = 0; q < 16; ++q) D[st][ri][q] = 0.f;
#pragma unroll
                    for (int ks = 0; ks < 4; ++ks) D[st][ri] = __builtin_amdgcn_mfma_f32_32x32x16_bf16(Af[ib2 + 2 * ri][ks], Bf[st][ks], D[st][ri], 0, 0, 0);
                }
            asm volatile("s_nop 15\n\ts_nop 15" ::: "memory");
            __builtin_amdgcn_sched_barrier(0);
#pragma unroll
            for (int r = 0; r < 16; ++r) {
                const int k1 = 32 * ib2 + (r & 3) + 8 * (r >> 2) + 4 * hh;
                const float2 tw = TW[n2 * 64 + k1];
                const float tr0 = D[0][0][r] * tw.x + D[0][1][r] * tw.y, ti0 = D[0][1][r] * tw.x - D[0][0][r] * tw.y;
                const float tr1 = D[1][0][r] * tw.x + D[1][1][r] * tw.y, ti1 = D[1][1][r] * tw.x - D[1][0][r] * tw.y;
                unsigned char* tp = (unsigned char*)T + ((size_t)b * SEQ + k1 * 64 + n2) * 2048 + col;
                *(unsigned short*)tp = (unsigned short)pk2_fp8(tr0, tr1); *(unsigned short*)(tp + 1024) = (unsigned short)pk2_fp8(ti0, ti1);
            }
        }
    }
}
DEV void phase_fnet_s2(const P& p) {
    const int tid = tid_(), lane = tid & 63, wid = __builtin_amdgcn_readfirstlane(tid >> 6);
    const int gw = (int)blockIdx.x * 8 + wid, GW = (int)gridDim.x * 8;
    const int jj = lane & 31, hh = lane >> 5;
    const bf16_t* F2 = (const bf16_t*)(p.ws + WS_F2);
    const bf16_t* T = (const bf16_t*)(p.ws + WS_R + R_T); bf16_t* Y = (bf16_t*)(p.ws + WS_R + R_Y);
    bf16x8 Af[2][8];
#pragma unroll
    for (int ib = 0; ib < 2; ++ib)
#pragma unroll
        for (int ks = 0; ks < 8; ++ks) Af[ib][ks] = *(const bf16x8*)(F2 + (size_t)ib * 64 * 128 + (size_t)jj * 128 + 16 * ks + 8 * hh);
    for (int it = gw; it < NB * 64 * 16; it += GW) {
        const int cb = it & 15, k1 = (it >> 4) & 63, b = it >> 10;
        const int col = 64 * cb + 2 * jj;
        const unsigned char* tb = (const unsigned char*)T + ((size_t)b * SEQ + k1 * 64) * 2048 + col;
        f32x16 D[2][2];
#pragma unroll
        for (int st = 0; st < 2; ++st)
#pragma unroll
            for (int ib = 0; ib < 2; ++ib)
#pragma unroll
                for (int q = 0; q < 16; ++q) D[st][ib][q] = 0.f;
        unsigned short wq[8][8];
#pragma unroll
        for (int ks = 0; ks < 8; ++ks)
#pragma unroll
            for (int t = 0; t < 8; ++t) { const int kk = 16 * ks + 8 * hh + t; wq[ks][t] = *(const unsigned short*)(tb + (size_t)(kk & 63) * 2048 + (kk >> 6) * 1024); }
        __builtin_amdgcn_sched_barrier(0);
        float a0 = 0.f, a1 = 0.f;
#pragma unroll
        for (int ks = 0; ks < 8; ++ks) {
            unsigned short w[8];
#pragma unroll
            for (int t = 0; t < 8; ++t) w[t] = wq[ks][t];
            f32x2 f[8];
#pragma unroll
            for (int t = 0; t < 8; ++t) f[t] = __builtin_amdgcn_cvt_pk_f32_fp8((int)w[t], false);
            if (ks < 4 && k1 == 0) {
#pragma unroll
                for (int t = 0; t < 8; ++t) { a0 += (t & 1) ? -f[t][0] : f[t][0]; a1 += (t & 1) ? -f[t][1] : f[t][1]; } }
            u32x4 e0, e1;
            e0.x = pk_bf16(f[0][0], f[1][0]); e0.y = pk_bf16(f[2][0], f[3][0]); e0.z = pk_bf16(f[4][0], f[5][0]); e0.w = pk_bf16(f[6][0], f[7][0]);
            e1.x = pk_bf16(f[0][1], f[1][1]); e1.y = pk_bf16(f[2][1], f[3][1]); e1.z = pk_bf16(f[4][1], f[5][1]); e1.w = pk_bf16(f[6][1], f[7][1]);
            const bf16x8 b0 = __builtin_bit_cast(bf16x8, e0), b1 = __builtin_bit_cast(bf16x8, e1);
#pragma unroll
            for (int ib = 0; ib < 2; ++ib) { D[0][ib] = __builtin_amdgcn_mfma_f32_32x32x16_bf16(Af[ib][ks], b0, D[0][ib], 0, 0, 0); D[1][ib] = __builtin_amdgcn_mfma_f32_32x32x16_bf16(Af[ib][ks], b1, D[1][ib], 0, 0, 0); }
        }
        asm volatile("s_nop 15\n\ts_nop 15" ::: "memory");
        __builtin_amdgcn_sched_barrier(0);
#pragma unroll
        for (int ib = 0; ib < 2; ++ib)
#pragma unroll
            for (int r = 0; r < 16; ++r) {
                const int k2 = (r & 3) + 8 * (r >> 2) + 4 * hh;
                *(unsigned short*)((unsigned char*)Y + ((size_t)b * 2048 + k1 + 64 * k2) * 2048 + ib * 1024 + col) = (unsigned short)pk2_fp8(D[0][ib][r] * F8_SY, D[1][ib][r] * F8_SY);
            }
        if (k1 == 0) {
            a0 += __shfl_xor(a0, 32); a1 += __shfl_xor(a1, 32);
            if (hh == 0) *(float2*)((float*)(p.ws + WS_Y2048) + b * 1024 + col) = make_float2(a0, a1);
        }
    }
}

constexpr int LDS_BYTES = 144 * 1024;
constexpr int LDS_BARW = 128 * 1024;
constexpr int LDS_TAB = 128 * 1024 + 64;
constexpr int NPHASE = 18;

template <int PH, bool DUMMY = false>
DEV void run_phase(const P& p, LAS unsigned char* lds) {
    void* const dummy_out = (void*)(p.ws + WS_R + 128 * MB_);
    bf16_t* const dummy_out13 = (bf16_t*)(p.ws + WS_R + R_T);
    bf16_t* const XA = (bf16_t*)(p.ws + WS_XA);
    const float* mod0 = (const float*)(p.ws + WS_MOD); const float* mod1 = mod0 + 9 * 6144;
    if constexpr (PH == 0) phase_prologue(p, lds);
    const bool ctx1 = gridDim.x >= CTX_D0 + 48;
    if constexpr (PH == 1) {
        if (ctx1) {
            const int bid = (int)blockIdx.x, dd = bid - CTX_D0;
            unsigned* done = (unsigned*)(p.ws + WS_CNT + 12 * KB_);
            phase_norm_plain<true, false, true>(p, p.x, MTOK, MALL, bid, (int)gridDim.x, p.norm_mix, mod0, 0, 1024);
            asm volatile("s_waitcnt vmcnt(0)" ::: "memory"); __syncthreads();
            if (threadIdx.x == 0) { __builtin_amdgcn_fence(__ATOMIC_RELEASE, "agent"); (void)xb_add(done, 1u); }
            { JobFold J{p}; g8::gemm_phase(lds, J); } phase_mod_final(p);
            if (dd >= 0 && dd < 48) {
                if (threadIdx.x == 0) { unsigned sp = 0; while (xb_ld(done) < gridDim.x && ++sp < XB_SPIN_CAP) __builtin_amdgcn_s_sleep(2); __builtin_amdgcn_fence(__ATOMIC_ACQUIRE, "agent"); }
                __syncthreads();
                const int t = dd >> 3;
                if (t < 2) { JobInProj<false, true> J{p, 2}; g8::gemm_phase(lds, J); } else if (t < 4) { JobInProj<true, true> J{p, 2}; g8::gemm_phase(lds, J); } else { JobInProj<false, false> J{p, 2}; g8::gemm_phase(lds, J); }
            }
            phase_norm_plain<true, false, true>(p, p.x, 0, MTOK, dd < 48 ? -1 : bid - (CTX_D0 + 48), (int)gridDim.x - (CTX_D0 + 48), p.norm_mix, mod0, 0, 1024);
        } else { { JobFold J{p}; g8::gemm_phase(lds, J); } phase_mod_final(p); phase_norm_plain<true, false, true>(p, p.x, 0, MALL, (int)blockIdx.x, (int)gridDim.x, p.norm_mix, mod0, 0, 1024); } }
    if constexpr (PH == 2) { const int md = ctx1 ? 1 : 0; { JobInProj<false, true> J{p, md}; g8::gemm_phase(lds, J); } { JobInProj<true, true> J{p, md}; g8::gemm_phase(lds, J); } { JobInProj<false, false> J{p, md}; g8::gemm_phase(lds, J); } }
    if constexpr (PH == 3) { phase_attention(p, lds); phase_lru1(p, lds); }
    if constexpr (PH == 4) phase_lru_carry(p);
    if constexpr (PH == 5) phase_lru2(p);
    if constexpr (PH == 6) { JobResid<1024, false> J{(const bf16_t*)(p.ws + WS_R + R_MIX), (const bf16_t*)(p.ws + WS_WOUT), p.x, XA, mod0 + 2048}; g8::gemm_phase(lds, J); }
    if constexpr (PH == 7) phase_norm_router(p, lds, XA, p.norm_ffn, mod0, DUMMY ? 2 : 0);
    if constexpr (PH == 8) { moe_build_tab((const unsigned*)(p.ws + WS_CNT), (LAS MoeTab*)(lds + LDS_TAB));
        { JobGateUp J{p, 0, (const LAS MoeTab*)(lds + LDS_TAB)}; g8::gemm_phase(lds, J); }
        { JobDown<false> J{p, 0, (const LAS MoeTab*)(lds + LDS_TAB), DUMMY ? dummy_out : (void*)XA}; g8::gemm_phase(lds, J); } }
    if constexpr (PH == 9) { }
    if constexpr (PH == 10) { }
    if constexpr (PH == 11) phase_fnet_s1(p, lds);
    if constexpr (PH == 12) phase_fnet_s2(p);
    if constexpr (PH == 13) { { JobHerm<0> J{p, XA}; g8::gemm_phase(lds, J); } asm volatile("s_waitcnt vmcnt(0)" ::: "memory"); __syncthreads(); { JobHerm<1> J{p, XA}; g8::gemm_phase(lds, J); } phase_herm_row2048(p, lds, XA); }
    if constexpr (PH == 14) { }
    if constexpr (PH == 15) phase_norm_router(p, lds, XA, p.norm_ffn + DM, mod1, DUMMY ? 3 : 1);
    if constexpr (PH == 16) { moe_build_tab((const unsigned*)(p.ws + WS_CNT) + 1024, (LAS MoeTab*)(lds + LDS_TAB));
        { JobGateUp J{p, 1, (const LAS MoeTab*)(lds + LDS_TAB)}; g8::gemm_phase(lds, J); }
        { JobDown<true> J{p, 1, (const LAS MoeTab*)(lds + LDS_TAB), DUMMY ? dummy_out : (void*)p.out}; g8::gemm_phase(lds, J); } }
    if constexpr (PH == 17) { }
}

#if MK_MULTI
template <int PH> __global__ void __launch_bounds__(NTHREADS, 2) k_phase(P p) {
    extern __shared__ __attribute__((aligned(16))) unsigned char shm[];
    run_phase<PH>(p, (LAS unsigned char*)shm);
}
template <int PH> static void launch_one(const P& p, int grid, hipStream_t s) {
    static bool attr = false; if (!attr) { (void)hipFuncSetAttribute((const void*)k_phase<PH>, hipFuncAttributeMaxDynamicSharedMemorySize, LDS_BYTES); attr = true; }
    hipLaunchKernelGGL((k_phase<PH>), dim3(grid), dim3(NTHREADS), LDS_BYTES, s, p);
}
template <int PH> static void launch_all(const P& p, int grid, hipStream_t s) { launch_one<PH>(p, grid, s); if constexpr (PH + 1 < NPHASE && PH < MK_LAST_PHASE) launch_all<PH + 1>(p, grid, s); }
#else
DEV P load_params() {
    typedef const unsigned long long __attribute__((address_space(4))) * KP;
    KP pp = (KP)__builtin_amdgcn_kernarg_segment_ptr();
    asm volatile("" : "+s"(pp));
    P r;
    typedef const float __attribute__((address_space(1))) * GF; typedef float __attribute__((address_space(1))) * GFW; typedef unsigned char __attribute__((address_space(1))) * GB;
#define LP_(i, f) r.f = (const float*)(GF)pp[i]
    LP_(0, x); LP_(1, c); LP_(2, ctx); LP_(3, c_ctx); LP_(4, ada_w); LP_(5, ada_b); LP_(6, norm_mix); LP_(7, norm_ffn); LP_(8, mix_w_in); LP_(9, mix_w_out); LP_(10, qn); LP_(11, kn); LP_(12, rpb);
    LP_(13, conv_w); LP_(14, conv_b); LP_(15, gr_w); LP_(16, gr_b); LP_(17, gi_w); LP_(18, gi_b); LP_(19, lam); LP_(20, fnet_w); LP_(21, router_w); LP_(22, router_b); LP_(23, wg); LP_(24, wu); LP_(25, wd);
#undef LP_
    r.out = (float*)(GFW)pp[26]; r.ws = (unsigned char*)(GB)pp[27];
    return r;
}
template <int PH> DEV void run_all(LAS unsigned char* lds) {
#ifdef MK_REP_MASK
    if constexpr (((MK_REP_MASK) >> PH) & 1) {
        { const P p = load_params(); run_phase<PH, true>(p, lds); }
        { const P pb = load_params(); XcdBarrier bar; bar.bar = (unsigned*)(pb.ws + WS_BAR); bar.x = xb_xcc_id(); bar.st = (volatile LAS unsigned*)(lds + LDS_BARW); xcd_barrier(bar); }
    }
#endif
    { const P p = load_params(); run_phase<PH>(p, lds); }
    if constexpr (PH + 1 < NPHASE && PH < MK_LAST_PHASE) {
        if constexpr (PH != 13 && PH != 9 && PH != 8 && PH != 16) { const P pb = load_params();
          XcdBarrier bar; bar.bar = (unsigned*)(pb.ws + WS_BAR); bar.x = xb_xcc_id(); bar.st = (volatile LAS unsigned*)(lds + LDS_BARW);
          xcd_barrier(bar); }
        run_all<PH + 1>(lds);
    }
}
__global__ void __launch_bounds__(NTHREADS, 2) k_mega(P p) {
    extern __shared__ __attribute__((aligned(16))) unsigned char shm[];
    LAS unsigned char* lds = (LAS unsigned char*)shm;
    if (threadIdx.x == 0) *(LAS u32x4*)(lds + LDS_BARW) = (u32x4){0u, 0u, 0u, 0u};
    __syncthreads();
    (void)xcd_barrier_post((unsigned*)(p.ws + WS_BAR), (volatile LAS unsigned*)(lds + LDS_BARW));
    run_all<0>(lds);
}
#endif

extern "C" void kernel_launch(void* const* d_in, const int* in_sizes, int n_in, void* d_out, int out_size, void* d_ws, size_t ws_size, hipStream_t stream) {
    static int grid = 0;
    if (grid == 0) {
        if (n_in != 26 || out_size != MTOK * DM || ws_size < WS_END) { fprintf(stderr, "kernel_launch: unexpected problem (n_in %d out %d ws %zu need %zu)\n", n_in, out_size, ws_size, (size_t)WS_END); grid = -1; return; }
        int dev = 0, cus = 0; (void)hipGetDevice(&dev); (void)hipDeviceGetAttribute(&cus, hipDeviceAttributeMultiprocessorCount, dev);
#if !MK_MULTI
        if (hipFuncSetAttribute((const void*)k_mega, hipFuncAttributeMaxDynamicSharedMemorySize, LDS_BYTES) != hipSuccess) { fprintf(stderr, "kernel_launch: hipFuncSetAttribute failed\n"); grid = -1; return; }
        int per_cu = 0; (void)hipOccupancyMaxActiveBlocksPerMultiprocessor(&per_cu, (const void*)k_mega, NTHREADS, LDS_BYTES);
        if (per_cu < 1) { fprintf(stderr, "kernel_launch: occupancy query says %d blocks per CU\n", per_cu); }
#endif
        grid = cus > 0 ? (cus / 8) * 8 : 256; if (grid < 8) grid = 8;
    }
    if (grid < 0) return;
    P p{};
    const float** f = (const float**)&p;
    for (int i = 0; i < 26; ++i) f[i] = (const float*)d_in[i];
    p.out = (float*)d_out; p.ws = (unsigned char*)d_ws;
    (void)hipMemsetAsync(d_ws, 0, WS_ZERO_BYTES, stream);
#if MK_MULTI
    launch_all<0>(p, grid, stream);
#else
    hipLaunchKernelGGL(k_mega, dim3(grid), dim3(NTHREADS), LDS_BYTES, stream, p);
#endif
}
```
